# Optimizing an MI355X kernel written in HIP

```python
import math, functools
import jax, jax.numpy as jnp
from jax import lax
import numpy as np

D_MODEL = 1024
BATCH = 8
SEQ = 2048
DEPTH = 1
DEC_BATCH = 32
DEC_SEQ = 8
PAST_LEN = 8192
PAGE_SIZE = 128

D_MIX = D_MODEL
A_HEADS = 4
A_DK = 128
A_DV = 128
A_WIDTH = A_HEADS * A_DV
B_HEADS = 8
B_DH = 64
B_WIDTH = B_HEADS * B_DH
IDX_HEADS = 16
IDX_DIM = 64
TOPK_MAX = 256
ROPE_THETA = 500000.0
B_ROT = B_DH // 4
IDX_ROT = IDX_DIM // 4
HGRN_CHUNK = 64
Q_BLOCK = 128
LN_EPS = 1e-5
ALPHA = (2.0 * DEPTH) ** 0.25
BETA = (8.0 * DEPTH) ** -0.25
IN_WIDTHS = (A_HEADS * A_DK, A_HEADS * A_DK, A_WIDTH, A_WIDTH,
             B_WIDTH, B_WIDTH, B_WIDTH, B_WIDTH,
             IDX_HEADS * IDX_DIM, IDX_DIM, IDX_HEADS)
IN_OFFSETS = tuple(sum(IN_WIDTHS[: i + 1]) for i in range(len(IN_WIDTHS) - 1))
D_IN = sum(IN_WIDTHS)

kernel_name = "hymba_hgrn2_dsa_deepnorm_step"


def layer_norm(x, g, b):
    xf = x.astype(jnp.float32)
    mu = jnp.mean(xf, -1, keepdims=True)
    var = jnp.mean(jnp.square(xf - mu), -1, keepdims=True)
    return ((xf - mu) * lax.rsqrt(var + LN_EPS) * g + b).astype(x.dtype)


def rms_norm(x, g):
    xf = x.astype(jnp.float32)
    return xf * lax.rsqrt(jnp.mean(xf * xf, -1, keepdims=True) + LN_EPS) * g


def partial_rope(x, pos, rot):
    half = rot // 2
    inv = ROPE_THETA ** (-jnp.arange(half, dtype=jnp.float32) / half)
    ang = pos.astype(jnp.float32)[:, None] * inv[None, :]
    cos = jnp.cos(ang)[:, None, :]
    sin = jnp.sin(ang)[:, None, :]
    xf = x.astype(jnp.float32)
    x1, x2 = xf[..., :half], xf[..., half:rot]
    out = jnp.concatenate([x1 * cos - x2 * sin, x1 * sin + x2 * cos, xf[..., rot:]], -1)
    return out.astype(x.dtype)


def hgrn_lower_bounds(lb_logits):
    p = jax.nn.softmax(lb_logits.astype(jnp.float32), axis=0)
    return jnp.cumsum(p, axis=0)[:DEPTH]


def hgrn2_recurrence(q, k, v, logf, s0):
    B, L, H, _ = q.shape
    DV = v.shape[-1]
    c = math.gcd(L, HGRN_CHUNK)
    n = L // c

    def chunks(a):
        return a.astype(jnp.float32).reshape(B, n, c, H, a.shape[-1]).transpose(1, 0, 3, 2, 4)

    causal = jnp.tril(jnp.ones((c, c), dtype=bool))[:, :, None]

    def step(S, inp):
        qc, kc, vc, gc = inp
        cum = jnp.cumsum(gc, axis=2)
        o_inter = jnp.einsum('bhtk,bhkv->bhtv', qc * jnp.exp(cum), S)
        rel = jnp.where(causal, cum[:, :, :, None, :] - cum[:, :, None, :, :], -jnp.inf)
        scores = jnp.einsum('bhtk,bhsk,bhtsk->bhts', qc, kc, jnp.exp(rel))
        o_intra = jnp.einsum('bhts,bhsv->bhtv', scores, vc)
        last = cum[:, :, -1:, :]
        S_new = (jnp.exp(last[:, :, 0, :])[..., None] * S
                 + jnp.einsum('bhsk,bhsv->bhkv', kc * jnp.exp(last - cum), vc))
        return S_new, o_inter + o_intra

    s_final, o = lax.scan(step, s0.astype(jnp.float32),
                          (chunks(q), chunks(k), chunks(v), chunks(logf)))
    o = o.transpose(1, 0, 3, 2, 4).reshape(B, L, H, DV)
    return o, s_final


def hgrn2_branch(qa, fa, ia, ga, lb, norm_g, s0):
    B, L, _ = qa.shape
    hd = lambda a, d: a.reshape(B, L, A_HEADS, d)
    fa32 = fa.astype(jnp.float32)
    logf = jnp.log(lb + (1.0 - lb) * jax.nn.sigmoid(fa32))
    key = (1.0 - lb) * jax.nn.sigmoid(-fa32)
    o, s_new = hgrn2_recurrence(hd(jax.nn.silu(qa), A_DK), hd(key, A_DK),
                                hd(ia, A_DV), hd(logf, A_DK), s0)
    o = rms_norm(o, norm_g).reshape(B, L, A_WIDTH)
    return o * jax.nn.silu(ga.astype(jnp.float32)), s_new


def dsa_inputs(qb, kb, vb, qi, ki, wi, pos, kn_g, kn_b):
    B, L, _ = qb.shape
    q = partial_rope(qb.reshape(B, L, B_HEADS, B_DH), pos, B_ROT)
    k = partial_rope(kb.reshape(B, L, B_HEADS, B_DH), pos, B_ROT)
    v = vb.reshape(B, L, B_HEADS, B_DH)
    qi = partial_rope(qi.reshape(B, L, IDX_HEADS, IDX_DIM), pos, IDX_ROT)
    ki = partial_rope(layer_norm(ki, kn_g, kn_b)[:, :, None, :], pos, IDX_ROT)[:, :, 0, :]
    wi = wi * (IDX_HEADS ** -0.5 * IDX_DIM ** -0.5)
    return q, k, v, qi, ki, wi


def indexer_scores(qi, wi, ki, qpos, kpos):
    rel = jax.nn.relu(jnp.einsum('bthd,bsd->bths', qi.astype(jnp.float32), ki.astype(jnp.float32)))
    s = jnp.einsum('bths,bth->bts', rel, wi.astype(jnp.float32))
    return jnp.where(kpos[None, None, :] <= qpos[None, :, None], s, -jnp.inf)


def attend_selected(q, kg, vg, valid):
    logits = jnp.einsum('bthd,btkhd->bhtk', q.astype(jnp.float32), kg.astype(jnp.float32)) * (B_DH ** -0.5)
    logits = jnp.where(valid[:, None], logits, -jnp.inf)
    p = jax.nn.softmax(logits, axis=-1)
    return jnp.einsum('bhtk,btkhd->bthd', p, vg.astype(jnp.float32))


def dsa_prompt(q, k, v, qi, ki, wi):
    B, L = q.shape[:2]
    topk = min(TOPK_MAX, L // 4)
    blk = math.gcd(L, Q_BLOCK)
    kpos = jnp.arange(L, dtype=jnp.int32)
    gather = jax.vmap(lambda rows, idx: rows[idx])

    def one_block(i):
        start = i * blk
        qpos = start + jnp.arange(blk, dtype=jnp.int32)
        sl = lambda a: lax.dynamic_slice_in_dim(a, start, blk, axis=1)
        scores = indexer_scores(sl(qi), sl(wi), ki, qpos, kpos)
        _, sel = lax.top_k(scores, topk)
        valid = sel <= qpos[None, :, None]
        return attend_selected(sl(q), gather(k, sel), gather(v, sel), valid)

    o = lax.map(one_block, jnp.arange(L // blk))
    return o.transpose(1, 0, 2, 3, 4).reshape(B, L, B_HEADS, B_DH)


def dsa_sample(q, k, v, qi, ki, wi, cache_k, cache_v, cache_kidx, page_table, layer):
    Bd, T = q.shape[:2]
    n_pages = page_table.shape[1]
    page = cache_k.shape[2]
    past = n_pages * page
    L = past + T
    topk = min(TOPK_MAX, L // 4)
    ki_past = cache_kidx[page_table, layer].reshape(Bd, past, IDX_DIM)
    ki_all = jnp.concatenate([ki_past.astype(jnp.float32), ki.astype(jnp.float32)], axis=1)
    qpos = past + jnp.arange(T, dtype=jnp.int32)
    kpos = jnp.arange(L, dtype=jnp.int32)
    scores = indexer_scores(qi, wi, ki_all, qpos, kpos)
    _, sel = lax.top_k(scores, topk)
    valid = sel <= qpos[None, :, None]
    from_past = (sel < past)[..., None, None]
    p_sel = jnp.minimum(sel, past - 1)
    phys = jnp.take_along_axis(page_table, (p_sel // page).reshape(Bd, -1), axis=1).reshape(p_sel.shape)
    off = p_sel % page
    n_sel = jnp.clip(sel - past, 0, T - 1)
    gather = jax.vmap(lambda rows, idx: rows[idx])
    kg = jnp.where(from_past, cache_k[phys, layer, off].astype(jnp.float32), gather(k, n_sel).astype(jnp.float32))
    vg = jnp.where(from_past, cache_v[phys, layer, off].astype(jnp.float32), gather(v, n_sel).astype(jnp.float32))
    return attend_selected(q, kg, vg, valid)


def merge_and_norm(x, o_a, o_b, g_b, w_out_l, ln_g_l, ln_b_l):
    B, L, _ = x.shape
    o_b = o_b.reshape(B, L, B_WIDTH) * jax.nn.silu(g_b.astype(jnp.float32))
    mix = jnp.concatenate([o_a, o_b], axis=-1).astype(x.dtype)
    y = jnp.einsum('ble,ed->bld', mix, w_out_l)
    return layer_norm(ALPHA * x + y, ln_g_l, ln_b_l)


def layer_forward(x, pos, s0, attend, w_in_l, lb_l, norm_g_l, kn_g_l, kn_b_l, w_out_l, ln_g_l, ln_b_l):
    h = jnp.einsum('bld,de->ble', x, w_in_l)
    qa, fa, ia, ga, qb, kb, vb, gb, qi, ki, wi = jnp.split(h, IN_OFFSETS, axis=-1)
    o_a, s_new = hgrn2_branch(qa, fa, ia, ga, lb_l, norm_g_l, s0)
    q, k, v, qi, ki, wi = dsa_inputs(qb, kb, vb, qi, ki, wi, pos, kn_g_l, kn_b_l)
    o_b = attend(q, k, v, qi, ki, wi)
    x_new = merge_and_norm(x, o_a, o_b, gb, w_out_l, ln_g_l, ln_b_l)
    return x_new, k, v, ki, s_new


def setup_inputs(seed: int = 0) -> dict:
    key = jax.random.key(seed)
    ks = jax.random.split(key, 16)
    n_pages = PAST_LEN // PAGE_SIZE
    n_used = DEC_BATCH * n_pages
    n_pool = (n_used * 5) // 4
    f32 = jnp.float32
    nrm = lambda k, shape, s: s * jax.random.normal(k, shape, f32)
    page_table = jax.random.permutation(ks[0], n_pool)[:n_used].reshape(DEC_BATCH, n_pages).astype(jnp.int32)
    return {
        "x_prompt": nrm(ks[1], (BATCH, SEQ, D_MODEL), 1.0),
        "x_sample": nrm(ks[2], (DEC_BATCH, DEC_SEQ, D_MODEL), 1.0),
        "cache_k": nrm(ks[3], (n_pool, DEPTH, PAGE_SIZE, B_HEADS, B_DH), 1.0),
        "cache_v": nrm(ks[4], (n_pool, DEPTH, PAGE_SIZE, B_HEADS, B_DH), 1.0),
        "cache_kidx": nrm(ks[5], (n_pool, DEPTH, PAGE_SIZE, IDX_DIM), 1.0),
        "state_hgrn": nrm(ks[6], (DEPTH, DEC_BATCH, A_HEADS, A_DK, A_DV), 0.5),
        "page_table": page_table,
        "w_in": nrm(ks[7], (DEPTH, D_MODEL, D_IN), D_MODEL ** -0.5),
        "hgrn_lb_logits": nrm(ks[8], (DEPTH + 1, A_HEADS * A_DK), 0.5),
        "hgrn_norm_g": 1.0 + nrm(ks[9], (DEPTH, A_DV), 0.02),
        "idx_norm_g": 1.0 + nrm(ks[10], (DEPTH, IDX_DIM), 0.02),
        "idx_norm_b": nrm(ks[11], (DEPTH, IDX_DIM), 0.02),
        "w_out": nrm(ks[12], (DEPTH, D_MIX, D_MODEL), BETA * D_MIX ** -0.5),
        "ln_g": 1.0 + nrm(ks[13], (DEPTH, D_MODEL), 0.02),
        "ln_b": nrm(ks[14], (DEPTH, D_MODEL), 0.02),
    }


def reference(x_prompt, x_sample, cache_k, cache_v, cache_kidx, state_hgrn, page_table,
              w_in, hgrn_lb_logits, hgrn_norm_g, idx_norm_g, idx_norm_b, w_out, ln_g, ln_b):
    lbs = hgrn_lower_bounds(hgrn_lb_logits)
    B, L, _ = x_prompt.shape
    Bd, T, _ = x_sample.shape
    page = cache_k.shape[2]
    past = page_table.shape[1] * page
    pos_p = jnp.arange(L, dtype=jnp.int32)
    pos_s = past + jnp.arange(T, dtype=jnp.int32)
    s0_prompt = jnp.zeros((B, A_HEADS, A_DK, A_DV), jnp.float32)
    xp, xs = x_prompt, x_sample
    kp, vp, kip, sp = [], [], [], []
    ksm, vsm, kism, ssm = [], [], [], []
    for l in range(DEPTH):
        w_l = (w_in[l], lbs[l], hgrn_norm_g[l], idx_norm_g[l], idx_norm_b[l], w_out[l], ln_g[l], ln_b[l])
        xp, k, v, ki, s = layer_forward(xp, pos_p, s0_prompt, dsa_prompt, *w_l)
        kp.append(k.reshape(B, L // page, page, B_HEADS, B_DH))
        vp.append(v.reshape(B, L // page, page, B_HEADS, B_DH))
        kip.append(ki.reshape(B, L // page, page, IDX_DIM))
        sp.append(s)
        attend_s = functools.partial(dsa_sample, cache_k=cache_k, cache_v=cache_v,
                                     cache_kidx=cache_kidx, page_table=page_table, layer=l)
        xs, k, v, ki, s = layer_forward(xs, pos_s, state_hgrn[l], attend_s, *w_l)
        ksm.append(k)
        vsm.append(v)
        kism.append(ki)
        ssm.append(s)
    new_k_prompt = jnp.stack(kp, axis=2)
    new_v_prompt = jnp.stack(vp, axis=2)
    new_kidx_prompt = jnp.stack(kip, axis=2)
    new_state_prompt = jnp.stack(sp, axis=0)
    new_k_sample = jnp.stack(ksm, axis=1)
    new_v_sample = jnp.stack(vsm, axis=1)
    new_kidx_sample = jnp.stack(kism, axis=1)
    new_state_sample = jnp.stack(ssm, axis=0)
    return (xp, xs, new_k_prompt, new_v_prompt, new_kidx_prompt, new_state_prompt,
            new_k_sample, new_v_sample, new_kidx_sample, new_state_sample)
```

```cpp
#include <hip/hip_runtime.h>
#include <cstdio>
#include <cstdint>
constexpr int NWAVES = 8, NTHR = NWAVES * 64;
constexpr int DM = 1024, NB = 8, SEQ = 2048, DB = 32, DT = 8, PAST = 8192, PAGE = 128, NPAGES = 64;
constexpr int MP = NB * SEQ, MS = DB * DT, M = MP + MS;
constexpr int DIN = 5200, NPAD = 5376;
constexpr int AH = 4, ADK = 128, ADV = 128, BH = 8, BDH = 64, IH = 16, IDD = 64, TOPK = 256;
constexpr float LN_EPS = 1e-5f;
constexpr float ALPHA = 1.189207115002721f;
constexpr float C2 = 0.125f * 1.4426950408889634f;
constexpr size_t O_YP = 0, O_YS = O_YP + (size_t)MP * DM, O_KP = O_YS + (size_t)MS * DM, O_VP = O_KP + (size_t)MP * 512, O_KIP = O_VP + (size_t)MP * 512,
                 O_SP = O_KIP + (size_t)MP * 64, O_KS = O_SP + (size_t)NB * AH * ADK * ADV, O_VS = O_KS + (size_t)MS * 512, O_KIS = O_VS + (size_t)MS * 512,
                 O_SS = O_KIS + (size_t)MS * 64, O_END = O_SS + (size_t)DB * AH * ADK * ADV;
constexpr size_t MiB = 1u << 20;
constexpr size_t WS_CTL = 0, CTL_ZERO_BYTES = 1 * MiB;
constexpr size_t WS_WINT = 2 * MiB, WS_WOUTT = 13 * MiB, WS_ROPE = 15 * MiB, WS_LBV = 15 * MiB + 512 * 1024, WS_XB = 16 * MiB;
constexpr size_t WS_QA = 49 * MiB, WS_VA = 66 * MiB, WS_GA = 83 * MiB, WS_QB = 100 * MiB, WS_KB = 117 * MiB, WS_VB = 134 * MiB, WS_GB = 151 * MiB;
constexpr size_t WS_LOGF = 168 * MiB, WS_QI = 201 * MiB, WS_KI = 234 * MiB, WS_WI = 237 * MiB, WS_U = 239 * MiB, WS_ASC = 255 * MiB, WS_MASK = 256 * MiB;
constexpr size_t WS_MIX = 260 * MiB, WS_SCORES = 293 * MiB, WS_Y = 302 * MiB, WS_END = 368 * MiB;
constexpr int SC_LD = 8256;
constexpr int CW_TMO = 0, CW_BAR = 4096;
constexpr int RING_BYTES = 131072;
constexpr int LDS_BYTES = 163840;
constexpr int MISC_OFF = LDS_BYTES - 256;

namespace pg8 {
#define PG8_LAS __attribute__((address_space(3)))
typedef unsigned short bf16_t;
typedef short bf16x8 __attribute__((ext_vector_type(8)));
typedef float f32x4 __attribute__((ext_vector_type(4)));
typedef unsigned u32x4 __attribute__((ext_vector_type(4)));
constexpr int BM = 256, BK = 64, HALF = 128, HTB = HALF * BK * 2  , STAGE_BYTES = 8 * HTB, NXCD = 8, WGM = 8;

__host__ __device__ __forceinline__ int lds_byte(int r, int c) { const int st = (r >> 4) * 2 + (c >> 5), rr = r & 15, cc = c & 31, ob = rr * 64 + cc * 2; return st * 1024 + (ob ^ (((ob >> 9) & 1) << 5)); }
__host__ __device__ __forceinline__ void stage_rc(int b, int& R, int& C) { const int st = b / 1024, sb = b % 1024, swz = sb ^ (((sb >> 9) & 1) << 5); R = (st >> 1) * 16 + swz / 64; C = (st & 1) * 32 + (swz % 64) / 2; }
__host__ __device__ __forceinline__ int perm32(int rho) { const int n = rho >> 4, i = rho & 15; return 8 * (i >> 2) + 4 * n + (i & 3); }

struct Unit { int pm, pn; };
struct Gemm { const bf16_t* A; const bf16_t* Bt; int M, N, K; };

struct StaticOrder {
    int nM, nN, nwg, G, c;
    __host__ __device__ void init(int M, int N, int G_, int c_) { nM = M / BM; nN = N / BM; nwg = nM * nN; G = G_; c = c_; }
    __host__ __device__ bool next(int i, Unit& u) const {
        const long L = (long)i * G + c; if (L >= nwg) return false;
        int wgid = (int)L; { const int q = nwg / NXCD, r = nwg % NXCD, xcd = wgid % NXCD, off = wgid / NXCD; wgid = (xcd < r ? xcd * (q + 1) : r * (q + 1) + (xcd - r) * q) + off; }
        const int nig = WGM * nN, gid = wgid / nig, fm = gid * WGM, gsz = (nM - fm) < WGM ? (nM - fm) : WGM;
        u.pm = fm + ((wgid % nig) % gsz); u.pn = (wgid % nig) / gsz; return true;
    }
    __device__ __forceinline__ void a_ready(const Unit&) const {}
    __device__ __forceinline__ void done(const Unit&) const {}
};

__device__ __forceinline__ unsigned cvt_pk_bf16(float lo, float hi) { unsigned r; asm volatile("v_cvt_pk_bf16_f32 %0, %1, %2" : "=v"(r) : "v"(lo), "v"(hi)); return r; }
typedef float f32x2 __attribute__((ext_vector_type(2)));
__device__ __forceinline__ float sigmoidf_fast(float x) { return __builtin_amdgcn_rcpf(1.0f + __builtin_amdgcn_exp2f(-1.4426950408889634f * x)); }
__device__ __forceinline__ float siluf_fast(float x) { return x * sigmoidf_fast(x); }
__device__ __forceinline__ void st_bf16x8(bf16_t* p, const f32x4 a, const f32x4 b) {
    u32x4 w; w.x = cvt_pk_bf16(a[0], a[1]); w.y = cvt_pk_bf16(a[2], a[3]); w.z = cvt_pk_bf16(b[0], b[1]); w.w = cvt_pk_bf16(b[2], b[3]); *(u32x4*)p = w; }

struct EpiIn {
    static constexpr bool PERM = true, AFTER_DRAIN = false;
    unsigned char* ws; float* out; const float *kn_g, *kn_b;
    static constexpr int MPR = MP;
    static constexpr float c2 = C2;
    __device__ __forceinline__ bf16_t* buf512(int bi) const { return (bf16_t*)(ws + WS_QA + (size_t)bi * (WS_VA - WS_QA)); }
    __device__ __forceinline__ int rope_idx(int row) const { return row < MPR ? (row & 2047) : 2048 + ((row - MPR) & 7); }
    __device__ __forceinline__ void rope8(f32x4& v0, f32x4& v1, int row, int fq) const {
        f32x4 p0, p1;
#pragma unroll
        for (int j = 0; j < 4; ++j) { p0[j] = __shfl_xor(v0[j], 16); p1[j] = __shfl_xor(v1[j], 16); }
        if (fq < 2) {
            const f32x4* t = (const f32x4*)((const float*)(ws + WS_ROPE) + (size_t)rope_idx(row) * 16);
            const f32x4 t0 = t[0], t1 = t[1], t2 = t[2], t3 = t[3];
            const float sg = fq == 0 ? -1.f : 1.f;
            v0[0] = v0[0] * t0[0] + sg * p0[0] * t0[1]; v0[1] = v0[1] * t0[2] + sg * p0[1] * t0[3];
            v0[2] = v0[2] * t1[0] + sg * p0[2] * t1[1]; v0[3] = v0[3] * t1[2] + sg * p0[3] * t1[3];
            v1[0] = v1[0] * t2[0] + sg * p1[0] * t2[1]; v1[1] = v1[1] * t2[2] + sg * p1[1] * t2[3];
            v1[2] = v1[2] * t3[0] + sg * p1[2] * t3[1]; v1[3] = v1[3] * t3[2] + sg * p1[3] * t3[3];
        }
    }
    __device__ __forceinline__ void operator()(const f32x4 (&acc)[2][2][4][2], const Unit& u, int wr, int wc, int fr, int fq) const {
        const int pn = u.pn, row0 = u.pm * BM + wr * 64 + fr, cw = wc * 32 + 8 * fq;
        if (pn < 8) {
            if ((pn >> 1) == 1) {
                const int c0 = (pn & 1) * 256 + cw;
#pragma unroll
                for (int bj = 0; bj < 2; ++bj) { const int c = c0 + bj * HALF; const float* lbv = (const float*)(ws + WS_LBV); const f32x4 l0 = *(const f32x4*)(lbv + c), l1 = *(const f32x4*)(lbv + c + 4);
#pragma unroll
                    for (int ai = 0; ai < 2; ++ai)
#pragma unroll
                        for (int m = 0; m < 4; ++m) { const int row = row0 + ai * HALF + m * 16; f32x4 a = acc[ai][bj][m][0], b = acc[ai][bj][m][1];
#pragma unroll
                            for (int j = 0; j < 4; ++j) { a[j] = 0.6931471805599453f * __builtin_amdgcn_logf(l0[j] + (1.f - l0[j]) * sigmoidf_fast(a[j])); b[j] = 0.6931471805599453f * __builtin_amdgcn_logf(l1[j] + (1.f - l1[j]) * sigmoidf_fast(b[j])); }
                            float* o = (float*)(ws + WS_LOGF) + (size_t)row * 512 + c; *(f32x4*)o = a; *(f32x4*)(o + 4) = b; } }
            } else {
                bf16_t* dst = buf512((pn >> 1) == 0 ? 0 : (pn >> 1) - 1); const bool act = (pn >> 1) != 2;
                const int c0 = (pn & 1) * 256 + cw;
#pragma unroll
                for (int ai = 0; ai < 2; ++ai)
#pragma unroll
                    for (int m = 0; m < 4; ++m) { const int row = row0 + ai * HALF + m * 16;
#pragma unroll
                        for (int bj = 0; bj < 2; ++bj) { f32x4 a = acc[ai][bj][m][0], b = acc[ai][bj][m][1];
                            if (act) {
#pragma unroll
                                for (int j = 0; j < 4; ++j) { a[j] = siluf_fast(a[j]); b[j] = siluf_fast(b[j]); } }
                            st_bf16x8(dst + (size_t)row * 512 + c0 + bj * HALF, a, b); } }
            }
        } else if (pn < 16) {
            const int grp = (pn - 8) >> 1, c0 = (pn & 1) * 256 + cw;
            bf16_t* dst = buf512(3 + grp);
            const bool dorope = (grp < 2) && ((wc & 1) == 0);
#pragma unroll
            for (int ai = 0; ai < 2; ++ai)
#pragma unroll
                for (int m = 0; m < 4; ++m) { const int row = row0 + ai * HALF + m * 16;
#pragma unroll
                    for (int bj = 0; bj < 2; ++bj) { f32x4 a = acc[ai][bj][m][0], b = acc[ai][bj][m][1]; const int c = c0 + bj * HALF;
                        if (dorope) rope8(a, b, row, fq);
                        if (grp == 1 || grp == 2) { float* o = out + (row < MPR ? (grp == 1 ? O_KP : O_VP) + (size_t)row * 512 : (grp == 1 ? O_KS : O_VS) + (size_t)(row - MPR) * 512);
                            *(f32x4*)(o + c) = a; *(f32x4*)(o + c + 4) = b; }
                        if (grp == 0) { a = a * c2; b = b * c2; }
                        if (grp == 3) {
#pragma unroll
                            for (int j = 0; j < 4; ++j) { a[j] = siluf_fast(a[j]); b[j] = siluf_fast(b[j]); } }
                        st_bf16x8(dst + (size_t)row * 512 + c, a, b); } }
        } else if (pn < 20) {
            const int c0 = (pn - 16) * 256 + cw; const bool dorope = (wc & 1) == 0;
#pragma unroll
            for (int ai = 0; ai < 2; ++ai)
#pragma unroll
                for (int m = 0; m < 4; ++m) { const int row = row0 + ai * HALF + m * 16;
#pragma unroll
                    for (int bj = 0; bj < 2; ++bj) { f32x4 a = acc[ai][bj][m][0], b = acc[ai][bj][m][1];
                        if (dorope) rope8(a, b, row, fq);
                        st_bf16x8((bf16_t*)(ws + WS_QI) + (size_t)row * 1024 + c0 + bj * HALF, a, b); } }
        } else {
            if (wc == 0) {
                const f32x4 g00 = *(const f32x4*)(kn_g + 8 * fq), g01 = *(const f32x4*)(kn_g + 8 * fq + 4), g10 = *(const f32x4*)(kn_g + 32 + 8 * fq), g11 = *(const f32x4*)(kn_g + 36 + 8 * fq);
                const f32x4 b00 = *(const f32x4*)(kn_b + 8 * fq), b01 = *(const f32x4*)(kn_b + 8 * fq + 4), b10 = *(const f32x4*)(kn_b + 32 + 8 * fq), b11 = *(const f32x4*)(kn_b + 36 + 8 * fq);
#pragma unroll
                for (int ai = 0; ai < 2; ++ai)
#pragma unroll
                    for (int m = 0; m < 4; ++m) { const int row = row0 + ai * HALF + m * 16;
                        f32x4 a0 = acc[ai][0][m][0], a1 = acc[ai][0][m][1], c0v = acc[ai][1][m][0], c1v = acc[ai][1][m][1];
                        float s = ((a0[0] + a0[1]) + (a0[2] + a0[3])) + ((a1[0] + a1[1]) + (a1[2] + a1[3])) + ((c0v[0] + c0v[1]) + (c0v[2] + c0v[3])) + ((c1v[0] + c1v[1]) + (c1v[2] + c1v[3]));
                        s += __shfl_xor(s, 16); s += __shfl_xor(s, 32);
                        const float mu = s * (1.f / 64.f);
                        a0 = a0 - mu; a1 = a1 - mu; c0v = c0v - mu; c1v = c1v - mu;
                        float q = ((a0[0] * a0[0] + a0[1] * a0[1]) + (a0[2] * a0[2] + a0[3] * a0[3])) + ((a1[0] * a1[0] + a1[1] * a1[1]) + (a1[2] * a1[2] + a1[3] * a1[3]))
                                + ((c0v[0] * c0v[0] + c0v[1] * c0v[1]) + (c0v[2] * c0v[2] + c0v[3] * c0v[3])) + ((c1v[0] * c1v[0] + c1v[1] * c1v[1]) + (c1v[2] * c1v[2] + c1v[3] * c1v[3]));
                        q += __shfl_xor(q, 16); q += __shfl_xor(q, 32);
                        const float rs = 1.0f / sqrtf(q * (1.f / 64.f) + 1e-5f);
                        a0 = a0 * rs * g00 + b00; a1 = a1 * rs * g01 + b01; c0v = c0v * rs * g10 + b10; c1v = c1v * rs * g11 + b11;
                        rope8(a0, a1, row, fq);
                        float* o = out + (row < MPR ? O_KIP + (size_t)row * 64 : O_KIS + (size_t)(row - MPR) * 64);
                        *(f32x4*)(o + 8 * fq) = a0; *(f32x4*)(o + 8 * fq + 4) = a1; *(f32x4*)(o + 32 + 8 * fq) = c0v; *(f32x4*)(o + 36 + 8 * fq) = c1v;
                        bf16_t* kio = (bf16_t*)(ws + WS_KI) + (size_t)row * 64; st_bf16x8(kio + 8 * fq, a0, a1); st_bf16x8(kio + 32 + 8 * fq, c0v, c1v); }
            } else if (wc == 1) {
                if (fq < 2) {
#pragma unroll
                    for (int ai = 0; ai < 2; ++ai)
#pragma unroll
                        for (int m = 0; m < 4; ++m) { const int row = row0 + ai * HALF + m * 16;
                            float* o = (float*)(ws + WS_WI) + (size_t)row * 16 + 8 * fq; *(f32x4*)o = acc[ai][0][m][0] * 0.03125f; *(f32x4*)(o + 4) = acc[ai][0][m][1] * 0.03125f; }
                }
            }
        }
    }
};
struct EpiF32 {
    static constexpr bool PERM = false, AFTER_DRAIN = false;
    float* O; int ldc;
    __device__ __forceinline__ void operator()(const f32x4 (&acc)[2][2][4][2], const Unit& u, int wr, int wc, int fr, int fq) const {
        const int row0 = u.pm * BM + wr * 64 + fr, col0 = u.pn * BM + wc * 32 + 4 * fq;
#pragma unroll
        for (int ai = 0; ai < 2; ++ai)
#pragma unroll
            for (int m = 0; m < 4; ++m) { float* rowp = O + (size_t)(row0 + ai * HALF + m * 16) * ldc + col0;
#pragma unroll
                for (int bj = 0; bj < 2; ++bj)
#pragma unroll
                    for (int n = 0; n < 2; ++n) *(f32x4*)(rowp + bj * HALF + n * 16) = acc[ai][bj][m][n]; }
    }
};
template <class Epi, class Sched, bool ALIGN_EPI = false, bool SP2 = false>
__device__ __forceinline__ void gemm_phase(PG8_LAS unsigned char* lds, const Gemm g, const Sched& S, const Epi& E) {
    int tid_ = threadIdx.x; asm volatile("" : "+v"(tid_));
    const int tid = tid_, wid = __builtin_amdgcn_readfirstlane(tid >> 6), lane = tid & 63, wr = wid >> 2, wc = wid & 3, fr = lane & 15, fq = lane >> 4;
    const int K = g.K, nt = K / BK;
    unsigned voffA[2], voffB[2];
#pragma unroll
    for (int i = 0; i < 2; ++i) { int R, C; stage_rc(tid * 16 + i * 8192, R, C); const int Rb = Epi::PERM ? ((R & ~31) + perm32(R & 31)) : R;
        voffA[i] = (unsigned)(R * K + C) * 2u; voffB[i] = (unsigned)(Rb * K + C) * 2u; }
    const size_t kstep = (size_t)(BK * 2);
    const size_t hstep = (size_t)HALF * K * 2;
    const size_t tstep = 2 * hstep;
    const unsigned ldsw = (unsigned)wid * 1024u;
    const int aoff = lds_byte(wr * 64 + fr, fq * 8), boff = lds_byte(wc * 32 + fr, fq * 8);
#define PG8_SA(b, h) (((b) * 2 + (h)) * HTB)
#define PG8_SB(b, h) ((4 + (b) * 2 + (h)) * HTB)
#define PG8_STAGE(bufoff, gbase, voff) do { _Pragma("unroll") for (int _i = 0; _i < 2; ++_i) \
        __builtin_amdgcn_global_load_lds((const unsigned*)((const char*)(gbase) + (voff)[_i]), (PG8_LAS unsigned*)(lds + (bufoff) + ldsw + _i * 8192), 16, 0, 0); } while (0)
#define PG8_LDA(dst, b, h) do { _Pragma("unroll") for (int m = 0; m < 4; ++m) _Pragma("unroll") for (int k = 0; k < 2; ++k) dst[m][k] = *(const PG8_LAS bf16x8*)(lds + PG8_SA(b, h) + aoff + m * 2048 + k * 1024); } while (0)
#define PG8_LDB(dst, b, h) do { _Pragma("unroll") for (int n = 0; n < 2; ++n) _Pragma("unroll") for (int k = 0; k < 2; ++k) dst[n][k] = *(const PG8_LAS bf16x8*)(lds + PG8_SB(b, h) + boff + n * 2048 + k * 1024); } while (0)
#define PG8_MMA(ai, bj, At, Bt) do { __builtin_amdgcn_s_setprio(1); _Pragma("unroll") for (int m = 0; m < 4; ++m) _Pragma("unroll") for (int n = 0; n < 2; ++n) _Pragma("unroll") for (int k = 0; k < 2; ++k) \
        acc[ai][bj][m][n] = __builtin_amdgcn_mfma_f32_16x16x32_bf16(Bt[n][k], At[m][k], acc[ai][bj][m][n], 0, 0, 0); __builtin_amdgcn_s_setprio(0); } while (0)
#define PG8_WAIT_V(n) asm volatile("s_waitcnt vmcnt(" #n ")" ::: "memory")
#define PG8_WAIT_L(n) asm volatile("s_waitcnt lgkmcnt(" #n ")" ::: "memory")
#define PG8_BAR __builtin_amdgcn_s_barrier()
#define PG8_SCHED __builtin_amdgcn_sched_barrier(0)
    Unit cur, nxt; int ui = 0;
    if (!S.next(0, cur)) return;
    f32x4 acc[2][2][4][2];
#pragma unroll
    for (int a = 0; a < 2; ++a)
#pragma unroll
        for (int b = 0; b < 2; ++b)
#pragma unroll
            for (int m = 0; m < 4; ++m)
#pragma unroll
                for (int n = 0; n < 2; ++n) acc[a][b][m][n] = (f32x4){0.f, 0.f, 0.f, 0.f};
    bf16x8 At[4][2], B0[2][2], B1[2][2];
    const char* cA = (const char*)g.A + (size_t)cur.pm * tstep; const char* cB = (const char*)g.Bt + (size_t)cur.pn * tstep;
    S.a_ready(cur);
    if constexpr (SP2) {
        PG8_STAGE(PG8_SB(0, 0), cB, voffB); PG8_STAGE(PG8_SB(0, 1), cB + hstep, voffB); PG8_STAGE(PG8_SA(0, 0), cA, voffA); PG8_STAGE(PG8_SA(0, 1), cA + hstep, voffA);
        if (wr == 1) PG8_BAR;
        PG8_WAIT_V(2); PG8_BAR;
        PG8_STAGE(PG8_SB(1, 0), cB + kstep, voffB); PG8_STAGE(PG8_SA(1, 0), cA + kstep, voffA); PG8_STAGE(PG8_SB(1, 1), cB + hstep + kstep, voffB);
        PG8_WAIT_V(6); PG8_BAR;
    } else {
        PG8_STAGE(PG8_SB(0, 0), cB, voffB); PG8_STAGE(PG8_SA(0, 0), cA, voffA); PG8_STAGE(PG8_SB(0, 1), cB + hstep, voffB); PG8_STAGE(PG8_SA(0, 1), cA + hstep, voffA);
        if (wr == 1) PG8_BAR;
        PG8_WAIT_V(4); PG8_BAR;
        PG8_STAGE(PG8_SB(1, 0), cB + kstep, voffB); PG8_STAGE(PG8_SA(1, 0), cA + kstep, voffA); PG8_STAGE(PG8_SB(1, 1), cB + hstep + kstep, voffB);
        PG8_WAIT_V(6); PG8_BAR;
    }
    for (;;) {
        const bool has_next = S.next(ui + 1, nxt);
        const char* nA = has_next ? (const char*)g.A + (size_t)nxt.pm * tstep : cA; const char* nB = has_next ? (const char*)g.Bt + (size_t)nxt.pn * tstep : cB;
        for (int t = 0; t < nt; t += 2) {
            const bool last = (t == nt - 2);
            const char* a1 = cA + (size_t)(t + 1) * kstep;
            const char* a2 = last ? nA : cA + (size_t)(t + 2) * kstep; const char* b2 = last ? nB : cB + (size_t)(t + 2) * kstep;
            const char* a3 = a2 + kstep; const char* b3 = b2 + kstep;
            if (last && has_next) S.a_ready(nxt);
            if constexpr (SP2) {
            PG8_LDB(B0, 0, 0); PG8_LDB(B1, 0, 1); PG8_SCHED; PG8_LDA(At, 0, 0); PG8_STAGE(PG8_SA(1, 1), a1 + hstep, voffA);
            PG8_WAIT_V(8); PG8_WAIT_L(0); PG8_BAR; PG8_MMA(0, 0, At, B0); PG8_MMA(0, 1, At, B1); PG8_BAR; PG8_SCHED;
            PG8_LDA(At, 0, 1); PG8_STAGE(PG8_SB(0, 0), b2, voffB); PG8_STAGE(PG8_SB(0, 1), b2 + hstep, voffB); PG8_STAGE(PG8_SA(0, 0), a2, voffA);
            PG8_WAIT_V(8); PG8_WAIT_L(0); PG8_BAR; PG8_MMA(1, 0, At, B0); PG8_MMA(1, 1, At, B1); PG8_BAR; PG8_SCHED;
            PG8_LDB(B0, 1, 0); PG8_LDB(B1, 1, 1); PG8_SCHED; PG8_LDA(At, 1, 0); PG8_STAGE(PG8_SA(0, 1), a2 + hstep, voffA);
            PG8_WAIT_V(8); PG8_WAIT_L(0); PG8_BAR; PG8_MMA(0, 0, At, B0); PG8_MMA(0, 1, At, B1); PG8_BAR; PG8_SCHED;
            PG8_LDA(At, 1, 1); PG8_STAGE(PG8_SB(1, 0), b3, voffB); PG8_STAGE(PG8_SB(1, 1), b3 + hstep, voffB); PG8_STAGE(PG8_SA(1, 0), a3, voffA);
            PG8_WAIT_V(8); PG8_WAIT_L(0); PG8_BAR; PG8_MMA(1, 0, At, B0); PG8_MMA(1, 1, At, B1); PG8_BAR; PG8_SCHED;
            } else {
            PG8_LDB(B0, 0, 0); PG8_SCHED; PG8_LDA(At, 0, 0); PG8_STAGE(PG8_SA(1, 1), a1 + hstep, voffA);
            PG8_WAIT_L(8); PG8_BAR; PG8_WAIT_L(0); PG8_MMA(0, 0, At, B0); PG8_BAR; PG8_SCHED;
            PG8_LDB(B1, 0, 1); PG8_STAGE(PG8_SB(0, 0), b2, voffB);
            PG8_BAR; PG8_WAIT_L(0); PG8_MMA(0, 1, At, B1); PG8_BAR;
            PG8_LDA(At, 0, 1); PG8_STAGE(PG8_SA(0, 0), a2, voffA);
            PG8_BAR; PG8_WAIT_L(0); PG8_MMA(1, 0, At, B0); PG8_BAR; PG8_SCHED;
            PG8_STAGE(PG8_SB(0, 1), b2 + hstep, voffB);
            PG8_WAIT_V(6); PG8_BAR; PG8_MMA(1, 1, At, B1); PG8_BAR;
            PG8_LDB(B0, 1, 0); PG8_SCHED; PG8_LDA(At, 1, 0); PG8_STAGE(PG8_SA(0, 1), a2 + hstep, voffA);
            PG8_WAIT_L(8); PG8_BAR; PG8_WAIT_L(0); PG8_MMA(0, 0, At, B0); PG8_BAR; PG8_SCHED;
            PG8_LDB(B1, 1, 1); PG8_STAGE(PG8_SB(1, 0), b3, voffB);
            PG8_BAR; PG8_WAIT_L(0); PG8_MMA(0, 1, At, B1); PG8_BAR;
            PG8_LDA(At, 1, 1); PG8_STAGE(PG8_SA(1, 0), a3, voffA);
            PG8_BAR; PG8_WAIT_L(0); PG8_MMA(1, 0, At, B0); PG8_BAR; PG8_SCHED;
            PG8_STAGE(PG8_SB(1, 1), b3 + hstep, voffB);
            PG8_WAIT_V(6); PG8_BAR; PG8_MMA(1, 1, At, B1); PG8_BAR;
            }
        }
        if constexpr (ALIGN_EPI) { if (wr == 0) PG8_BAR; }
        if constexpr (!Epi::AFTER_DRAIN) { E(acc, cur, wr, wc, fr, fq); S.done(cur); }
        if (!has_next) break;
#pragma unroll
        for (int a = 0; a < 2; ++a)
#pragma unroll
            for (int b = 0; b < 2; ++b)
#pragma unroll
                for (int m = 0; m < 4; ++m)
#pragma unroll
                    for (int n = 0; n < 2; ++n) acc[a][b][m][n] = (f32x4){0.f, 0.f, 0.f, 0.f};
        cur = nxt; cA = nA; cB = nB; ++ui;
        if constexpr (ALIGN_EPI) { if (wr == 1) PG8_BAR; }
    }
    PG8_WAIT_V(0);
    if constexpr (!ALIGN_EPI) { if (wr == 0) PG8_BAR; }
    PG8_BAR;
    if constexpr (Epi::AFTER_DRAIN) { E.fused(acc, cur, wr, wc, fr, fq, lds, wid, lane); S.done(cur); }
#undef PG8_SA
#undef PG8_SB
#undef PG8_STAGE
#undef PG8_LDA
#undef PG8_LDB
#undef PG8_MMA
#undef PG8_WAIT_V
#undef PG8_WAIT_L
#undef PG8_BAR
#undef PG8_SCHED
}
}
#include <hip/hip_bf16.h>
#include <cmath>
namespace attn_body {
using bf16=__hip_bfloat16;
using bf16x8=__attribute__((ext_vector_type(8)))short;
using s16x4=__attribute__((ext_vector_type(4)))short;
using f32x16=__attribute__((ext_vector_type(16)))float;
using u32x4=__attribute__((ext_vector_type(4)))unsigned;
constexpr int BATCH=8,NHEAD=8,SEQ=2048,D=64,DM=NHEAD*D;
constexpr int NW=8,QBLK=32,QB=QBLK*NW,KVBLK=64,NQB=SEQ/QB;
constexpr int ATTN_PITCH=DM, ATTN_UNIT_ROWS=QB;
__device__ __forceinline__ int crow(int r,int hi){return (r&3)+8*(r>>2)+4*hi;}
#define SBAR() __builtin_amdgcn_sched_barrier(0)
__device__ __forceinline__ void cmask(f32x16&p0,f32x16&p1,int jb,int qrel,int hi){
  const float NEG=-INFINITY; int kb=64*jb+4*hi;
  #pragma unroll
  for(int r=0;r<16;++r){int kv=kb+(r&3)+8*(r>>2); if(kv>qrel)p0[r]=NEG; if(kv+32>qrel)p1[r]=NEG;}
}

constexpr int NSLOT=3, SLOTB=8192;
constexpr int LDS_K=0, LDS_V=NSLOT*SLOTB, LDS_WS=2*NSLOT*SLOTB, LDS_OST=LDS_WS+NW*64*4, LDS_MSK=LDS_OST+NW*4096, MSK_ROW=264, LDS_BYTES=LDS_MSK+NW*32*MSK_ROW;
constexpr float C2=0.125f*1.4426950408889634f;
__device__ __forceinline__ void glds16(const void*gsrc,unsigned lds_dst){unsigned keep;
  asm volatile("s_mov_b32 %0, m0\n\ts_mov_b32 m0, %2\n\ts_nop 0\n\tglobal_load_lds_dwordx4 %1, off\n\ts_mov_b32 m0, %0":"=&s"(keep):"v"(gsrc),"s"(lds_dst):"memory");}
__device__ __forceinline__ float max3f(float a,float b,float c){float r;asm("v_max3_f32 %0, %1, %2, %3":"=v"(r):"v"(a),"v"(b),"v"(c));return r;}
__device__ __forceinline__ float max2f(float a,float b){float r;asm("v_max_f32_e32 %0, %1, %2":"=v"(r):"v"(a),"v"(b));return r;}
__device__ __forceinline__ float fadd_s(float a,float b){float r;asm("v_add_f32_e32 %0, %1, %2":"=v"(r):"v"(a),"v"(b));return r;}
__device__ __forceinline__ float fsub_s(float a,float b){float r;asm("v_sub_f32_e32 %0, %1, %2":"=v"(r):"v"(a),"v"(b));return r;}
typedef float f32x2_t __attribute__((ext_vector_type(2))); typedef float f32x4_t __attribute__((ext_vector_type(4))); typedef __bf16 bf16x2_t __attribute__((ext_vector_type(2)));
__device__ __forceinline__ unsigned cvtpk_s(float lo,float hi){f32x2_t v={lo,hi};bf16x2_t b=__builtin_convertvector(v,bf16x2_t);return __builtin_bit_cast(unsigned,b);}
#define WAIT_BAR(N) asm volatile("s_waitcnt vmcnt(" #N ") lgkmcnt(0)\n\ts_barrier":::"memory")

__device__ __forceinline__ void qkt(f32x16&p0,f32x16&p1,const char*Kslot,const bf16x8*qr,const f32x16&negm,int r32,int hi){
  const char*kb=Kslot+hi*1024+r32*16;
  #pragma unroll
  for(int d0=0;d0<4;++d0){
    const bf16x8 b0=*reinterpret_cast<const bf16x8*>(kb+d0*2048);
    const bf16x8 b1=*reinterpret_cast<const bf16x8*>(kb+d0*2048+512);
    if(d0==0){p0=__builtin_amdgcn_mfma_f32_32x32x16_bf16(b0,qr[0],negm,0,0,0);p1=__builtin_amdgcn_mfma_f32_32x32x16_bf16(b1,qr[0],negm,0,0,0);}
    else{p0=__builtin_amdgcn_mfma_f32_32x32x16_bf16(b0,qr[d0],p0,0,0,0);p1=__builtin_amdgcn_mfma_f32_32x32x16_bf16(b1,qr[d0],p1,0,0,0);}}
}
typedef __attribute__((address_space(3))) const char* lds_cptr;
typedef short v4i16_t __attribute__((ext_vector_type(4)));
__device__ __forceinline__ void kload8(bf16x8*kf,lds_cptr kp){
  kf[0]=*(const __attribute__((address_space(3))) bf16x8*)(kp);      kf[1]=*(const __attribute__((address_space(3))) bf16x8*)(kp+512);
  kf[2]=*(const __attribute__((address_space(3))) bf16x8*)(kp+2048); kf[3]=*(const __attribute__((address_space(3))) bf16x8*)(kp+2560);
  kf[4]=*(const __attribute__((address_space(3))) bf16x8*)(kp+4096); kf[5]=*(const __attribute__((address_space(3))) bf16x8*)(kp+4608);
  kf[6]=*(const __attribute__((address_space(3))) bf16x8*)(kp+6144); kf[7]=*(const __attribute__((address_space(3))) bf16x8*)(kp+6656);
}
__device__ __forceinline__ void kload2(bf16x8*kf,lds_cptr kp,int j){ kf[2*j]=*(const __attribute__((address_space(3))) bf16x8*)(kp+j*2048); kf[2*j+1]=*(const __attribute__((address_space(3))) bf16x8*)(kp+j*2048+512); }
__device__ __forceinline__ s16x4 vtr(lds_cptr p){ return __builtin_bit_cast(s16x4,__builtin_amdgcn_ds_read_tr16_b64_v4i16((__attribute__((address_space(3))) v4i16_t*)p)); }
__device__ __forceinline__ float rowmax(const f32x16&p0,const f32x16&p1){
  float a=max3f(p0[0],p0[1],p1[0]),b=max3f(p0[2],p0[3],p1[1]);a=max3f(a,p1[2],p1[3]);
  #pragma unroll
  for(int r=4;r<16;r+=4){a=max3f(a,p0[r],p0[r+1]);b=max3f(b,p0[r+2],p0[r+3]);a=max3f(a,p1[r],p1[r+1]);b=max3f(b,p1[r+2],p1[r+3]);}
  const float m=max2f(a,b);
  auto rr=__builtin_amdgcn_permlane32_swap(__float_as_uint(m),__float_as_uint(m),false,false);
  return max2f(__uint_as_float(rr[0]),__uint_as_float(rr[1]));
}
__device__ __forceinline__ void pv(f32x16*o,int vb,bf16x8 pa0,bf16x8 pa1,bf16x8 pa2,bf16x8 pa3){
  #pragma unroll
  for(int d0=0;d0<2;++d0){s16x4 lo[4],hi[4];
    #pragma unroll
    for(int ks=0;ks<4;++ks){
      asm volatile("ds_read_b64_tr_b16 %0,%1 offset:%c2":"=&v"(lo[ks]):"v"(vb),"i"(d0*4096+ks*1024):"memory");
      asm volatile("ds_read_b64_tr_b16 %0,%1 offset:%c2":"=&v"(hi[ks]):"v"(vb),"i"(d0*4096+ks*1024+512):"memory");}
    asm volatile("s_waitcnt lgkmcnt(0)":::"memory");SBAR();
    #define PK(k) (bf16x8){lo[k][0],lo[k][1],lo[k][2],lo[k][3],hi[k][0],hi[k][1],hi[k][2],hi[k][3]}
    o[d0]=__builtin_amdgcn_mfma_f32_32x32x16_bf16(pa0,PK(0),o[d0],0,0,0);
    o[d0]=__builtin_amdgcn_mfma_f32_32x32x16_bf16(pa1,PK(1),o[d0],0,0,0);
    o[d0]=__builtin_amdgcn_mfma_f32_32x32x16_bf16(pa2,PK(2),o[d0],0,0,0);
    o[d0]=__builtin_amdgcn_mfma_f32_32x32x16_bf16(pa3,PK(3),o[d0],0,0,0);
    #undef PK
  }
}

#ifndef ATTN_STORE16
#define ATTN_STORE16(p,v) (*(u32x4*)(p)=(v))
#endif
template<int THRL> __device__ __forceinline__ void attn_unit(int b,int h,int qb,const bf16*Q,const bf16*__restrict__ K,const bf16*__restrict__ V,const unsigned*__restrict__ MSK,const unsigned short*__restrict__ GATE,unsigned short*MIXO,char*shm){
  const int tid=threadIdx.x,lane=tid&63,r32=lane&31,hi=lane>>5; const int wid=__builtin_amdgcn_readfirstlane(tid>>6);
  const long rowbase=(long)b*SEQ; const int q0=qb*QB;
  const bf16*Qw=Q+(rowbase+q0+wid*QBLK)*DM+h*D;
  const bf16*Kh=K+rowbase*DM+h*D,*Vh=V+rowbase*DM+h*D;
  const unsigned lds0=(unsigned)(uintptr_t)shm;
  float*wsf=(float*)(shm+LDS_WS)+wid*64;
  const lds_cptr shm3=(lds_cptr)shm;
  const bf16*ksrc=Kh+(long)lane*DM+wid*8;
  const bf16*vsrc=Vh+(long)(16*(wid&3)+(lane>>2))*DM+(wid>>2)*32+(lane&3)*8;
  const unsigned kdst=lds0+LDS_K+wid*1024, vdst=lds0+LDS_V+wid*1024;
  #define DMA_K(t,slot) glds16(ksrc+(long)(t)*KVBLK*DM,(unsigned)__builtin_amdgcn_readfirstlane(kdst+(slot)))
  #define DMA_V(t,slot) glds16(vsrc+(long)(t)*KVBLK*DM,(unsigned)__builtin_amdgcn_readfirstlane(vdst+(slot)))
  const int vb0=(int)(lds0+LDS_V)+((lane>>4)&1)*32+(lane&3)*8+(4*hi+((lane&15)>>2))*64;
  const char*Kbase=shm+LDS_K; bf16x8 kf[8];
  const lds_cptr kp0=shm3+LDS_K+hi*1024+r32*16; const lds_cptr vp0=shm3+LDS_V+((lane>>4)&1)*32+(lane&3)*8+(4*hi+((lane&15)>>2))*64;
  const int NT=(q0+QB)/KVBLK;
  { const unsigned*mg=MSK+(rowbase+q0+wid*QBLK)*64+lane; __attribute__((address_space(3))) unsigned*ml=(__attribute__((address_space(3))) unsigned*)(shm3+LDS_MSK+wid*32*MSK_ROW)+lane;
    #pragma unroll 8
    for(int i=0;i<32;++i){ const unsigned w=(lane<2*NT)?mg[(long)i*64]:0u; ml[i*(MSK_ROW/4)]=w; }
    asm volatile("s_waitcnt vmcnt(0) lgkmcnt(0)":::"memory"); }
  const lds_cptr mskp=shm3+LDS_MSK+wid*32*MSK_ROW+r32*MSK_ROW;
  #define LDMK(t) const unsigned long long mk_=*(const __attribute__((address_space(3))) unsigned long long*)(mskp+8*(t)); const unsigned mw0_=(unsigned)mk_>>(4*hi), mw1_=(unsigned)(mk_>>32)>>(4*hi)
  #define MK(v,W,bit) __builtin_bit_cast(float,__builtin_bit_cast(unsigned,(float)(v))&(unsigned)(((int)((W)<<(31-(bit))))>>31))
  #define MK16(P,W) do{ _Pragma("unroll") for(int r=0;r<16;++r)P[r]=MK(P[r],W,(r&3)+8*(r>>2)); }while(0)
  DMA_K(0,0);DMA_V(0,0);DMA_K(1,SLOTB);
  bf16x8 qr[4];
  #pragma unroll
  for(int d0=0;d0<4;++d0)qr[d0]=*reinterpret_cast<const bf16x8*>(&Qw[(long)r32*DM+d0*16+hi*8]);
  float mhat=0.f,l_reg=0.f;f32x16 o[2];o[0]=f32x16{};o[1]=f32x16{};f32x16 negm=f32x16{};asm volatile("":"+v"(negm));
  const int qrel=wid*QBLK+r32;
  #define CMASK(P0,P1,t) do{}while(0)
  bool resc=false;
  #define START(P0,P1) do{ const float rm=rowmax(P0,P1); resc=false; \
    { const float dl=rm; mhat=fadd_s(mhat,dl); \
      _Pragma("unroll") for(int r=0;r<16;++r){P0[r]=fsub_s(P0[r],dl);P1[r]=fsub_s(P1[r],dl);} \
      _Pragma("unroll") for(int r=0;r<16;++r)negm[r]=-mhat; asm volatile("":"+v"(negm)); } \
    _Pragma("unroll") for(int r=0;r<16;++r)P0[r]=__builtin_amdgcn_exp2f(P0[r]); }while(0)
  #define RESC() do{ if(resc){ asm volatile("s_waitcnt lgkmcnt(0)":::"memory"); \
      _Pragma("unroll") for(int d_=0;d_<2;++d_) _Pragma("unroll") for(int r=0;r<16;++r)o[d_][r]*=wsf[crow(r,hi)]; } }while(0)
  f32x16 pA0,pA1,pB0,pB1;
  int sl_prev=0,sl_cur=0,sl_next=SLOTB;
  #define ROT() do{sl_prev=sl_cur;sl_cur=sl_next;sl_next=(sl_next==(NSLOT-1)*SLOTB)?0:sl_next+SLOTB;}while(0)
  DMA_K(2,2*SLOTB);
  WAIT_BAR(3);
  qkt(pA0,pA1,Kbase,qr,negm,r32,hi);asm volatile("s_nop 15\n\ts_nop 7":"+v"(pA0),"+v"(pA1));CMASK(pA0,pA1,0);
  START(pA0,pA1);
  _Pragma("unroll") for(int r=0;r<16;++r)pA1[r]=__builtin_amdgcn_exp2f(pA1[r]);
  { LDMK(0); MK16(pA0,mw0_); MK16(pA1,mw1_); }
  WAIT_BAR(0);
  DMA_K(3,0);DMA_V(1,SLOTB);
  ROT();
  kload8(kf,kp0+sl_cur);
  WAIT_BAR(2);
  s16x4 vlo[8],vhi[8]; u32x4 pw0,pw1,pw2,pw3;
  #define PKW(P,B) cvtpk_s(P[B],P[B+1])
  #define PAF(k) __builtin_bit_cast(bf16x8,pw##k)
  #define VFR(i) (bf16x8){vlo[i][0],vlo[i][1],vlo[i][2],vlo[i][3],vhi[i][0],vhi[i][1],vhi[i][2],vhi[i][3]}
  #define PIN(x) asm volatile("":"+v"(x))
  #define MX3(a,b,c) __builtin_fmaxf(__builtin_fmaxf((a),(b)),(c))
  #define GAPA(MF,A0,A1,A2,A3,W0,W1,PW) do{ MF; sacc+=A0; sacc+=A1; sacc+=A2; sacc+=A3; PIN(sacc); W0; W1; PIN(PW); SBAR(); }while(0)
  #define EX(v) __builtin_amdgcn_exp2f(v)
  #define GAPB(MF,X,B,W) do{ MF; X[B]=MK(EX(X[B]),W,8*((B)>>2)); X[B+1]=MK(EX(X[B+1]),W,8*((B)>>2)+1); X[B+2]=MK(EX(X[B+2]),W,8*((B)>>2)+2); X[B+3]=MK(EX(X[B+3]),W,8*((B)>>2)+3); PIN(X); SBAR(); }while(0)
  #define VRD(i) do{ vlo[i]=vtr(vp_+(((i)>>2)*4096+((i)&3)*1024)); vhi[i]=vtr(vp_+(((i)>>2)*4096+((i)&3)*1024+512)); }while(0)
  #define KRD(G,j) do{ if(G){ kload2(kf,kp0+sl_next,j); SBAR(); } }while(0)
  #define STEP(C0,C1,P0,P1,t,GK,GV,GL) do{ SBAR(); LDMK(t); \
    const lds_cptr vp_=vp0+sl_prev; \
    VRD(0); SBAR(); float sacc=(P0[0]+P0[1]); \
    GAPA(C0=__builtin_amdgcn_mfma_f32_32x32x16_bf16(kf[0],qr[0],negm,0,0,0), P0[2],P0[3],P0[4],P0[5],     pw0[0]=PKW(P0,0), pw0[1]=PKW(P0,2), pw0); \
    VRD(4); SBAR(); GAPA(C1=__builtin_amdgcn_mfma_f32_32x32x16_bf16(kf[1],qr[0],negm,0,0,0), P0[6],P0[7],P0[8],P0[9],     pw0[2]=PKW(P0,4), pw0[3]=PKW(P0,6), pw0); \
    VRD(1); SBAR(); GAPA(C0=__builtin_amdgcn_mfma_f32_32x32x16_bf16(kf[2],qr[1],C0,0,0,0),   P0[10],P0[11],P0[12],P0[13], pw1[0]=PKW(P0,8), pw1[1]=PKW(P0,10), pw1); \
    VRD(5); SBAR(); GAPA(C1=__builtin_amdgcn_mfma_f32_32x32x16_bf16(kf[3],qr[1],C1,0,0,0),   P0[14],P0[15],P1[0],P1[1],   pw1[2]=PKW(P0,12),pw1[3]=PKW(P0,14), pw1); \
    VRD(2); SBAR(); GAPA(C0=__builtin_amdgcn_mfma_f32_32x32x16_bf16(kf[4],qr[2],C0,0,0,0),   P1[2],P1[3],P1[4],P1[5],     pw2[0]=PKW(P1,0), pw2[1]=PKW(P1,2), pw2); \
    VRD(6); SBAR(); GAPA(C1=__builtin_amdgcn_mfma_f32_32x32x16_bf16(kf[5],qr[2],C1,0,0,0),   P1[6],P1[7],P1[8],P1[9],     pw2[2]=PKW(P1,4), pw2[3]=PKW(P1,6), pw2); \
    VRD(3); SBAR(); GAPA(C0=__builtin_amdgcn_mfma_f32_32x32x16_bf16(kf[6],qr[3],C0,0,0,0),   P1[10],P1[11],P1[12],P1[13], pw3[0]=PKW(P1,8), pw3[1]=PKW(P1,10), pw3); \
    VRD(7); SBAR(); GAPA(C1=__builtin_amdgcn_mfma_f32_32x32x16_bf16(kf[7],qr[3],C1,0,0,0),   P1[14],P1[15],0.f,0.f,       pw3[2]=PKW(P1,12),pw3[3]=PKW(P1,14), pw3); \
    l_reg+=sacc; \
    if(GK){DMA_K((t)+3,sl_cur);} if(GV){DMA_V((t)+1,sl_next);} \
    CMASK(C0,C1,t); \
    { float a=MX3(C0[0],C0[1],C1[0]),b=MX3(C0[2],C0[3],C1[1]); a=MX3(a,C1[2],C1[3]); \
      _Pragma("unroll") for(int r=4;r<16;r+=4){a=MX3(a,C0[r],C0[r+1]);b=MX3(b,C0[r+2],C0[r+3]);a=MX3(a,C1[r],C1[r+1]);b=MX3(b,C1[r+2],C1[r+3]);} \
      float rm=__builtin_fmaxf(a,b); { auto rr=__builtin_amdgcn_permlane32_swap(__float_as_uint(rm),__float_as_uint(rm),false,false); rm=__builtin_fmaxf(__uint_as_float(rr[0]),__uint_as_float(rr[1])); } \
      resc=false; \
      if(__builtin_expect(__any(rm>(float)THRL),0)){ const float dl=__builtin_fmaxf(rm,0.f); mhat+=dl; \
        _Pragma("unroll") for(int r=0;r<16;++r){C0[r]-=dl;C1[r]-=dl;} \
        _Pragma("unroll") for(int r=0;r<16;++r)negm[r]=-mhat; asm volatile("":"+v"(negm)); \
        const float f=__builtin_amdgcn_exp2f(-dl); l_reg*=f; if(hi==0)wsf[r32]=f; resc=true; } } \
    SBAR(); \
    GAPB(o[0]=__builtin_amdgcn_mfma_f32_32x32x16_bf16(PAF(0),VFR(0),o[0],0,0,0), C0,0,mw0_); \
    GAPB(o[1]=__builtin_amdgcn_mfma_f32_32x32x16_bf16(PAF(0),VFR(4),o[1],0,0,0), C0,4,mw0_); \
    KRD(GL,0); GAPB(o[0]=__builtin_amdgcn_mfma_f32_32x32x16_bf16(PAF(1),VFR(1),o[0],0,0,0), C0,8,mw0_); \
    KRD(GL,1); GAPB(o[1]=__builtin_amdgcn_mfma_f32_32x32x16_bf16(PAF(1),VFR(5),o[1],0,0,0), C0,12,mw0_); \
    KRD(GL,2); GAPB(o[0]=__builtin_amdgcn_mfma_f32_32x32x16_bf16(PAF(2),VFR(2),o[0],0,0,0), C1,0,mw1_); \
    KRD(GL,3); GAPB(o[1]=__builtin_amdgcn_mfma_f32_32x32x16_bf16(PAF(2),VFR(6),o[1],0,0,0), C1,4,mw1_); \
    GAPB(o[0]=__builtin_amdgcn_mfma_f32_32x32x16_bf16(PAF(3),VFR(3),o[0],0,0,0), C1,8,mw1_); \
    GAPB(o[1]=__builtin_amdgcn_mfma_f32_32x32x16_bf16(PAF(3),VFR(7),o[1],0,0,0), C1,12,mw1_); \
    }while(0)
  int t=1;
  #undef CMASK
  #define CMASK(P0,P1,t) do{}while(0)
  for(;t+5<NT;t+=2){
    STEP(pB0,pB1,pA0,pA1,t,true,true,true);     WAIT_BAR(2); RESC(); ROT();
    STEP(pA0,pA1,pB0,pB1,t+1,true,true,true);   WAIT_BAR(2); RESC(); ROT();
  }
  #undef CMASK
  #define CMASK(P0,P1,t) do{}while(0)
  #define ENDW(tt) do{ if((tt)+3<NT){WAIT_BAR(2);} else if((tt)+2<NT){WAIT_BAR(1);} else {WAIT_BAR(0);} }while(0)
  for(;t+1<NT;t+=2){
    STEP(pB0,pB1,pA0,pA1,t,(t+3<NT),(t+1<NT),(t+1<NT));       ENDW(t);   RESC(); ROT();
    STEP(pA0,pA1,pB0,pB1,t+1,(t+4<NT),(t+2<NT),(t+2<NT));     ENDW(t+1); RESC(); ROT();
  }
  STEP(pB0,pB1,pA0,pA1,NT-1,false,false,false); RESC();
  { float sacc=pB0[0]+pB0[1]; _Pragma("unroll") for(int r=2;r<16;++r)sacc+=pB0[r]; _Pragma("unroll") for(int r=0;r<16;++r)sacc+=pB1[r]; l_reg+=sacc;
    pw0=(u32x4){PKW(pB0,0),PKW(pB0,2),PKW(pB0,4),PKW(pB0,6)};pw1=(u32x4){PKW(pB0,8),PKW(pB0,10),PKW(pB0,12),PKW(pB0,14)};pw2=(u32x4){PKW(pB1,0),PKW(pB1,2),PKW(pB1,4),PKW(pB1,6)};pw3=(u32x4){PKW(pB1,8),PKW(pB1,10),PKW(pB1,12),PKW(pB1,14)};
    SBAR(); pv(o,vb0+sl_cur,PAF(0),PAF(1),PAF(2),PAF(3)); }
  #undef PKW
  #undef PAF
  #undef VFR
  #undef PIN
  #undef MX3
  #undef GAPA
  #undef GAPB
  #undef EX
  #undef VRD
  #undef KRD
  #undef STEP
  #undef ENDW
  {auto rr=__builtin_amdgcn_permlane32_swap(__float_as_uint(l_reg),__float_as_uint(l_reg),false,false);l_reg=__uint_as_float(rr[0])+__uint_as_float(rr[1]);}
  if(hi==0)wsf[32+r32]=l_reg;asm volatile("s_waitcnt lgkmcnt(0)":::"memory");
  float rli[16];
  #pragma unroll
  for(int r=0;r<16;++r)rli[r]=__builtin_amdgcn_rcpf(wsf[32+crow(r,hi)]);
  { float*stgf=(float*)(shm+LDS_OST)+wid*1024; const long orow0=rowbase+q0+wid*QBLK;
    #pragma unroll
    for(int d0=0;d0<2;++d0){
      #pragma unroll
      for(int r=0;r<16;++r)stgf[crow(r,hi)*32+r32]=o[d0][r]*rli[r];
      asm volatile("s_waitcnt lgkmcnt(0)":::"memory");
      #pragma unroll
      for(int i=0;i<4;++i){const int row=i*8+(lane>>3),c4=(lane&7)*4; const f32x4_t v=*(const f32x4_t*)(stgf+row*32+c4);
        const unsigned long long gw=*(const unsigned long long*)(GATE+(orow0+row)*512+h*64+d0*32+c4);
        const float g0=__builtin_bit_cast(float,(unsigned)gw<<16),g1=__builtin_bit_cast(float,(unsigned)gw&0xffff0000u),g2=__builtin_bit_cast(float,(unsigned)(gw>>32)<<16),g3=__builtin_bit_cast(float,(unsigned)(gw>>32)&0xffff0000u);
        const unsigned long long ov=(unsigned long long)cvtpk_s(v[0]*g0,v[1]*g1)|((unsigned long long)cvtpk_s(v[2]*g2,v[3]*g3)<<32);
        *(unsigned long long*)(MIXO+(orow0+row)*1024+512+h*64+d0*32+c4)=ov;}
      asm volatile("s_waitcnt lgkmcnt(0)":::"memory"); } }
  asm volatile("s_waitcnt lgkmcnt(0)\n\ts_barrier":::"memory");
  #undef DMA_K
  #undef LDMK
  #undef MK
  #undef MK16
  #undef DMA_V
  #undef CMASK
  #undef START
  #undef RESC
  #undef ROT
}
constexpr int ATTN_LDS_BYTES=LDS_BYTES;
#undef SBAR
#undef WAIT_BAR
}
#define GAS __attribute__((address_space(1)))
#define LAS __attribute__((address_space(3)))
typedef unsigned short bf16;
typedef unsigned v4u __attribute__((ext_vector_type(4)));
typedef float f32x4 __attribute__((ext_vector_type(4)));
typedef short bf16x8 __attribute__((ext_vector_type(8)));
typedef GAS unsigned gu32;
typedef GAS unsigned long long gu64;
#define RLX_AGENT __ATOMIC_RELAXED, __HIP_MEMORY_SCOPE_AGENT
#define LDS_WAIT() asm volatile("s_waitcnt lgkmcnt(0)" ::: "memory")
#define VM_WAIT() asm volatile("s_waitcnt vmcnt(0)" ::: "memory")
__device__ __forceinline__ unsigned long long rt() { return __builtin_amdgcn_s_memrealtime(); }
__device__ __forceinline__ unsigned f2bf(float f) { unsigned u = __builtin_bit_cast(unsigned, f); return (u + 0x7fffu + ((u >> 16) & 1u)) >> 16; }
__device__ __forceinline__ unsigned pk2(float lo, float hi) { return f2bf(lo) | (f2bf(hi) << 16); }

#define XB_TMO      128
#define XB_XCNT(j)  (256  + 64 * (j))
#define XB_XSUB(j)  (1280 + 64 * (j))
#define XB_XGEN(j)  (2304 + 64 * (j))
#define XB_TOP      3328
#define XB_TOPGEN   3392
#define XCD_BAR_WORDS 3456
#define XB_SPIN_CAP (1u << 18)

__device__ __forceinline__ unsigned xb_ld(unsigned* p)              { return __hip_atomic_load(p, __ATOMIC_RELAXED, __HIP_MEMORY_SCOPE_AGENT); }
__device__ __forceinline__ unsigned xb_add(unsigned* p, unsigned v) { return __hip_atomic_fetch_add(p, v, __ATOMIC_RELAXED, __HIP_MEMORY_SCOPE_AGENT); }
__device__ __forceinline__ unsigned xb_xcc_id() { return (unsigned)__builtin_amdgcn_s_getreg((3 << 11) | 20) & 0xFu; }
#define XB_SPIN(cond, bar) do { unsigned _sp = 0; while (cond) { __builtin_amdgcn_s_sleep(1); \
    if ((++_sp & 255u) == 0u) { if (xb_ld(&(bar)[XB_TMO])) break; if (_sp > XB_SPIN_CAP) { atomicAdd(&(bar)[XB_TMO], 1u); break; } } } } while (0)

struct XcdBarrier {
    unsigned* bar; unsigned x;
    volatile LAS unsigned* st;
};

__device__ __forceinline__ XcdBarrier xcd_barrier_post(unsigned* bar, volatile LAS unsigned* st) {
    XcdBarrier b; b.bar = bar; b.x = xb_xcc_id(); b.st = st;
    if (threadIdx.x == 0) (void)xb_add(&bar[XB_XCNT(b.x)], 1u);
    return b;
}
__device__ __forceinline__ void xcd_barrier_complete(unsigned* bar, unsigned x, unsigned& nloc, unsigned& nx) {
    const unsigned G = gridDim.x * gridDim.y * gridDim.z;
    unsigned sum, cnt, mine, sp = 0u;
    for (;;) {
        sum = 0u; cnt = 0u; mine = 0u;
#pragma unroll
        for (unsigned j = 0; j < 16; ++j) { const unsigned c = xb_ld(&bar[XB_XCNT(j)]); sum += c; cnt += (c > 0u) ? 1u : 0u; mine = (j == x) ? c : mine; }
        if (sum == G) break;
        __builtin_amdgcn_s_sleep(1);
        if ((++sp & 255u) == 0u) { if (xb_ld(&bar[XB_TMO])) break; if (sp > XB_SPIN_CAP) { atomicAdd(&bar[XB_TMO], 1u); break; } }
    }
    nloc = mine > 0u ? mine : 1u; nx = cnt > 0u ? cnt : 1u;
}

__device__ __forceinline__ void xcd_barrier(const XcdBarrier& b) {
    asm volatile("s_waitcnt vmcnt(0)" ::: "memory");
    __syncthreads();
    if (threadIdx.x == 0) {
        unsigned* bar = b.bar;
        __builtin_amdgcn_s_waitcnt(0);
        unsigned nloc = b.st[0], nx = b.st[1];
        if (nloc == 0u) { xcd_barrier_complete(bar, b.x, nloc, nx); b.st[0] = nloc; b.st[1] = nx; }
        const unsigned old = xb_add(&bar[XB_XSUB(b.x)], 1u);
        const unsigned gen = old / nloc;
        if (old + 1u == (gen + 1u) * nloc) {
            __builtin_amdgcn_fence(__ATOMIC_RELEASE, "agent");
            asm volatile("s_waitcnt vmcnt(0)" ::: "memory");
            const unsigned og = xb_add(&bar[XB_TOP], 1u);
            const unsigned tg = og / nx;
            if (og + 1u == (tg + 1u) * nx) xb_add(&bar[XB_TOPGEN], 1u);
            else XB_SPIN(xb_ld(&bar[XB_TOPGEN]) == tg, bar);
            __builtin_amdgcn_fence(__ATOMIC_ACQUIRE, "agent");
            xb_add(&bar[XB_XGEN(b.x)], 1u);
            asm volatile("s_waitcnt vmcnt(0)" ::: "memory");
        } else {
            XB_SPIN(xb_ld(&bar[XB_XGEN(b.x)]) == gen, bar);
            __builtin_amdgcn_fence(__ATOMIC_ACQUIRE, "agent");
            asm volatile("s_waitcnt vmcnt(0)" ::: "memory");
        }
    }
    __syncthreads();
}
typedef float f32x16 __attribute__((ext_vector_type(16)));
typedef unsigned short us8 __attribute__((ext_vector_type(8)));
__device__ __forceinline__ float bf2f(unsigned short h) { return __builtin_bit_cast(float, (unsigned)h << 16); }
__device__ __forceinline__ float ex2(float x) { return __builtin_amdgcn_exp2f(x); }
constexpr float LOG2E = 1.4426950408889634f;
__device__ __forceinline__ float wave_sum(float v) {
#pragma unroll
    for (int o = 1; o < 64; o <<= 1) v += __shfl_xor(v, o);
    return v;
}
constexpr int HG_QT = 0, HG_KT = 17408, HG_KTT = 34816, HG_VT = 53248, HG_SB = 71680, HG_P = 106496, HG_OB = 115712, HG_AL = 149504, HG_SEG = 150016, HG_END = 152064;
constexpr int ST_K = 272, ST_T = 144, ST_O = 528;
static_assert(HG_END <= MISC_OFF, "HGRN LDS map");
__device__ __forceinline__ bf16x8 ldfrag(const LAS unsigned char* base, int row, int stride, int kelem) { return *(const LAS bf16x8*)(base + row * stride + kelem * 2); }

template <bool FULL>
__device__ __forceinline__ void hgrn_prompt_unit(LAS unsigned char* L, unsigned char* ws, float* out, const float* norm_g, int unit, int tid) {
    const int lane = tid & 63, wave = __builtin_amdgcn_readfirstlane(tid >> 6), r32 = lane & 31, hh = lane >> 5;
    const int b = unit >> 5, h = (unit >> 3) & 3, sc = unit & 7;
    const float* LOGF = (const float*)(ws + WS_LOGF); const bf16* QA = (const bf16*)(ws + WS_QA); const bf16* VA = (const bf16*)(ws + WS_VA); const bf16* GA = (const bf16*)(ws + WS_GA);
    float* U = (float*)(ws + WS_U); float* ASC = (float*)(ws + WS_ASC); bf16* MIX = (bf16*)(ws + WS_MIX);
    const int kch = tid & 127, seg = tid >> 7;
    const int vi = wave & 3, kp = wave >> 2;
    f32x16 S0 = {}, S1 = {};
    if (FULL) {
        for (int j = 0; j < sc; ++j) { const int uj = unit - sc + j; const float* Uj = U + (size_t)uj * 16384; const float* Aj = ASC + uj * 128;
#pragma unroll
            for (int r = 0; r < 16; ++r) { const int k0 = 64 * kp + (r & 3) + 8 * (r >> 2) + 4 * hh;
                S0[r] = Aj[k0] * S0[r] + Uj[k0 * 128 + 32 * vi + r32]; S1[r] = Aj[k0 + 32] * S1[r] + Uj[(k0 + 32) * 128 + 32 * vi + r32]; } }
#pragma unroll
        for (int g = 0; g < 4; ++g) { unsigned long long w0 = (unsigned long long)pk2(S0[4 * g], S0[4 * g + 1]) | ((unsigned long long)pk2(S0[4 * g + 2], S0[4 * g + 3]) << 32);
            unsigned long long w1 = (unsigned long long)pk2(S1[4 * g], S1[4 * g + 1]) | ((unsigned long long)pk2(S1[4 * g + 2], S1[4 * g + 3]) << 32);
            *(LAS unsigned long long*)(L + HG_SB + (32 * vi + r32) * ST_K + (64 * kp + 8 * g + 4 * hh) * 2) = w0;
            *(LAS unsigned long long*)(L + HG_SB + (32 * vi + r32) * ST_K + (64 * kp + 32 + 8 * g + 4 * hh) * 2) = w1; }
    }
    float atot = 0.f;
    for (int c = 0; c < 4; ++c) {
        const int row0 = b * SEQ + sc * 256 + c * 64;
        float cum[16]; { float run = 0.f;
#pragma unroll
            for (int i = 0; i < 16; ++i) { run += LOGF[(size_t)(row0 + seg * 16 + i) * 512 + h * 128 + kch]; cum[i] = run; }
            ((LAS float*)(L + HG_SEG))[seg * 128 + kch] = run; }
        unsigned short vv[16];
#pragma unroll
        for (int i = 0; i < 16; ++i) vv[i] = VA[(size_t)(row0 + seg * 16 + i) * 512 + h * 128 + kch];
        unsigned short qq[16];
        if (FULL) {
#pragma unroll
            for (int i = 0; i < 16; ++i) qq[i] = QA[(size_t)(row0 + seg * 16 + i) * 512 + h * 128 + kch]; }
        __syncthreads();
        { const LAS float* sg = (const LAS float*)(L + HG_SEG); const float t0 = sg[kch], t1 = sg[128 + kch], t2 = sg[256 + kch], t3 = sg[384 + kch];
          const float off = seg == 0 ? 0.f : (seg == 1 ? t0 : (seg == 2 ? t0 + t1 : t0 + t1 + t2)); const float tot = (t0 + t1) + (t2 + t3);
          if (seg == 0) { ((LAS float*)(L + HG_AL))[kch] = ex2(tot * LOG2E); atot += tot; }
          unsigned short kt[16], qt[16]; float prev = 0.f;
#pragma unroll
          for (int i = 0; i < 16; ++i) { const float g = cum[i] - prev; prev = cum[i]; const float cm = cum[i] + off;
              const float f = ex2(g * LOG2E); const float kk = (1.f - f) * ex2(-cm * LOG2E); kt[i] = (unsigned short)f2bf(kk);
              if (FULL) { const float qv = bf2f(qq[i]) * ex2(cm * LOG2E); qt[i] = (unsigned short)f2bf(qv);
                  *(LAS unsigned short*)(L + HG_QT + (seg * 16 + i) * ST_K + kch * 2) = qt[i]; *(LAS unsigned short*)(L + HG_KT + (seg * 16 + i) * ST_K + kch * 2) = kt[i]; } }
          us8 w0, w1, x0, x1;
#pragma unroll
          for (int i = 0; i < 8; ++i) { w0[i] = kt[i]; w1[i] = kt[8 + i]; x0[i] = vv[i]; x1[i] = vv[8 + i]; }
          *(LAS us8*)(L + HG_KTT + kch * ST_T + seg * 32) = w0; *(LAS us8*)(L + HG_KTT + kch * ST_T + seg * 32 + 16) = w1;
          *(LAS us8*)(L + HG_VT + kch * ST_T + seg * 32) = x0; *(LAS us8*)(L + HG_VT + kch * ST_T + seg * 32 + 16) = x1; }
        __syncthreads();
        f32x16 o = {};
        if (FULL) {
            const int ti = wave >> 2;
            if (wave < 3) { const int si = wave == 2 ? 1 : 0, tj = wave == 0 ? 0 : 1; f32x16 p = {};
#pragma unroll
                for (int ks = 0; ks < 8; ++ks) p = __builtin_amdgcn_mfma_f32_32x32x16_bf16(ldfrag(L + HG_KT, 32 * si + r32, ST_K, 16 * ks + 8 * hh), ldfrag(L + HG_QT, 32 * tj + r32, ST_K, 16 * ks + 8 * hh), p, 0, 0, 0);
                const int t = 32 * tj + r32;
#pragma unroll
                for (int g = 0; g < 4; ++g) { float e[4];
#pragma unroll
                    for (int j = 0; j < 4; ++j) { const int s = 32 * si + 8 * g + 4 * hh + j; e[j] = s <= t ? p[4 * g + j] : 0.f; }
                    *(LAS unsigned long long*)(L + HG_P + t * ST_T + (32 * si + 8 * g + 4 * hh) * 2) = (unsigned long long)pk2(e[0], e[1]) | ((unsigned long long)pk2(e[2], e[3]) << 32); } }
#pragma unroll
            for (int ks = 0; ks < 8; ++ks) o = __builtin_amdgcn_mfma_f32_32x32x16_bf16(ldfrag(L + HG_QT, 32 * ti + r32, ST_K, 16 * ks + 8 * hh), ldfrag(L + HG_SB, 32 * vi + r32, ST_K, 16 * ks + 8 * hh), o, 0, 0, 0);
            __syncthreads();
#pragma unroll
            for (int ks = 0; ks < 4; ++ks) if (ks < 2 * (ti + 1)) o = __builtin_amdgcn_mfma_f32_32x32x16_bf16(ldfrag(L + HG_P, 32 * ti + r32, ST_T, 16 * ks + 8 * hh), ldfrag(L + HG_VT, 32 * vi + r32, ST_T, 16 * ks + 8 * hh), o, 0, 0, 0);
        }
#pragma unroll
        for (int ks = 0; ks < 4; ++ks) { const bf16x8 bv = ldfrag(L + HG_VT, 32 * vi + r32, ST_T, 16 * ks + 8 * hh);
            S0 = __builtin_amdgcn_mfma_f32_32x32x16_bf16(ldfrag(L + HG_KTT, 64 * kp + r32, ST_T, 16 * ks + 8 * hh), bv, S0, 0, 0, 0);
            S1 = __builtin_amdgcn_mfma_f32_32x32x16_bf16(ldfrag(L + HG_KTT, 64 * kp + 32 + r32, ST_T, 16 * ks + 8 * hh), bv, S1, 0, 0, 0); }
        { const LAS float* al = (const LAS float*)(L + HG_AL);
#pragma unroll
          for (int r = 0; r < 16; ++r) { const int k0 = 64 * kp + (r & 3) + 8 * (r >> 2) + 4 * hh; S0[r] *= al[k0]; S1[r] *= al[k0 + 32]; } }
        if (FULL) {
#pragma unroll
            for (int g = 0; g < 4; ++g) { unsigned long long w0 = (unsigned long long)pk2(S0[4 * g], S0[4 * g + 1]) | ((unsigned long long)pk2(S0[4 * g + 2], S0[4 * g + 3]) << 32);
                unsigned long long w1 = (unsigned long long)pk2(S1[4 * g], S1[4 * g + 1]) | ((unsigned long long)pk2(S1[4 * g + 2], S1[4 * g + 3]) << 32);
                *(LAS unsigned long long*)(L + HG_SB + (32 * vi + r32) * ST_K + (64 * kp + 8 * g + 4 * hh) * 2) = w0;
                *(LAS unsigned long long*)(L + HG_SB + (32 * vi + r32) * ST_K + (64 * kp + 32 + 8 * g + 4 * hh) * 2) = w1; }
            const int ti = wave >> 2;
#pragma unroll
            for (int r = 0; r < 16; ++r) *(LAS float*)(L + HG_OB + (32 * ti + (r & 3) + 8 * (r >> 2) + 4 * hh) * ST_O + (32 * vi + r32) * 4) = o[r];
            __syncthreads();
            { const int t = tid >> 3, j = tid & 7; const LAS float* ob = (const LAS float*)(L + HG_OB + t * ST_O) + 16 * j; float v[16]; float ss = 0.f;
#pragma unroll
              for (int i = 0; i < 4; ++i) { const f32x4 x = *(const LAS f32x4*)(ob + 4 * i); v[4 * i] = x[0]; v[4 * i + 1] = x[1]; v[4 * i + 2] = x[2]; v[4 * i + 3] = x[3]; ss += (x[0] * x[0] + x[1] * x[1]) + (x[2] * x[2] + x[3] * x[3]); }
              ss += __shfl_xor(ss, 1); ss += __shfl_xor(ss, 2); ss += __shfl_xor(ss, 4);
              const float rs = 1.0f / sqrtf(ss * (1.f / 128.f) + LN_EPS);
              const size_t gi = (size_t)(row0 + t) * 512 + h * 128 + 16 * j; const v4u g0 = *(const GAS v4u*)(GA + gi), g1 = *(const GAS v4u*)(GA + gi + 8);
              const unsigned gw[8] = {g0.x, g0.y, g0.z, g0.w, g1.x, g1.y, g1.z, g1.w}; unsigned ow[8];
#pragma unroll
              for (int i = 0; i < 8; ++i) { const float ga = __builtin_bit_cast(float, gw[i] << 16), gb = __builtin_bit_cast(float, gw[i] & 0xffff0000u);
                  ow[i] = pk2(v[2 * i] * rs * norm_g[16 * j + 2 * i] * ga, v[2 * i + 1] * rs * norm_g[16 * j + 2 * i + 1] * gb); }
              bf16* mo = MIX + (size_t)(row0 + t) * 1024 + h * 128 + 16 * j;
              *(GAS v4u*)mo = (v4u){ow[0], ow[1], ow[2], ow[3]}; *(GAS v4u*)(mo + 8) = (v4u){ow[4], ow[5], ow[6], ow[7]}; }
        }
    }
    if (!FULL) {
        float* Uu = U + (size_t)unit * 16384;
#pragma unroll
        for (int r = 0; r < 16; ++r) { const int k0 = 64 * kp + (r & 3) + 8 * (r >> 2) + 4 * hh; Uu[k0 * 128 + 32 * vi + r32] = S0[r]; Uu[(k0 + 32) * 128 + 32 * vi + r32] = S1[r]; }
        if (seg == 0) ASC[unit * 128 + kch] = ex2(atot * LOG2E);
    } else if (sc == 7) {
        float* So = out + O_SP + (size_t)(b * 4 + h) * 16384;
#pragma unroll
        for (int r = 0; r < 16; ++r) { const int k0 = 64 * kp + (r & 3) + 8 * (r >> 2) + 4 * hh; So[k0 * 128 + 32 * vi + r32] = S0[r]; So[(k0 + 32) * 128 + 32 * vi + r32] = S1[r]; }
    }
    __syncthreads();
}

__device__ __forceinline__ void hgrn_sample_unit(LAS unsigned char* L, unsigned char* ws, float* out, const float* state_in, const float* norm_g, int unit, int tid) {
    const int b = unit >> 2, h = unit & 3, v = tid & 127, kq = tid >> 7;
    const float* LOGF = (const float*)(ws + WS_LOGF); const bf16* QA = (const bf16*)(ws + WS_QA); const bf16* VA = (const bf16*)(ws + WS_VA); const bf16* GA = (const bf16*)(ws + WS_GA); bf16* MIX = (bf16*)(ws + WS_MIX);
    LAS float* qt = (LAS float*)L; LAS float* kt = qt + 1024; LAS float* vv = kt + 1024; LAS float* al = vv + 1024; LAS float* part = al + 128;
    const int row0 = MP + b * 8;
    float S[32]; const float* Sin = state_in + (size_t)unit * 16384;
#pragma unroll
    for (int i = 0; i < 32; ++i) S[i] = Sin[(kq * 32 + i) * 128 + v];
    if (tid < 128) { float cm = 0.f;
#pragma unroll
        for (int t = 0; t < 8; ++t) { const size_t gi = (size_t)(row0 + t) * 512 + h * 128 + tid; const float g = LOGF[gi]; cm += g;
            qt[t * 128 + tid] = bf2f(QA[gi]) * ex2(cm * LOG2E); kt[t * 128 + tid] = (1.f - ex2(g * LOG2E)) * ex2(-cm * LOG2E); }
        al[tid] = ex2(cm * LOG2E); }
    else if (tid < 256) { const int vc = tid - 128;
#pragma unroll
        for (int t = 0; t < 8; ++t) vv[t * 128 + vc] = bf2f(VA[(size_t)(row0 + t) * 512 + h * 128 + vc]); }
    __syncthreads();
#pragma unroll
    for (int t = 0; t < 8; ++t) { const float vt = vv[t * 128 + v]; float acc = 0.f;
#pragma unroll
        for (int i = 0; i < 32; ++i) { S[i] += kt[t * 128 + kq * 32 + i] * vt; acc += qt[t * 128 + kq * 32 + i] * S[i]; }
        part[(t * 4 + kq) * 128 + v] = acc; }
    float* So = out + O_SS + (size_t)unit * 16384;
#pragma unroll
    for (int i = 0; i < 32; ++i) So[(kq * 32 + i) * 128 + v] = S[i] * al[kq * 32 + i];
    __syncthreads();
    { const int t = tid >> 6, l = tid & 63; const float o0 = (part[(t * 4) * 128 + l] + part[(t * 4 + 1) * 128 + l]) + (part[(t * 4 + 2) * 128 + l] + part[(t * 4 + 3) * 128 + l]);
      const float o1 = (part[(t * 4) * 128 + 64 + l] + part[(t * 4 + 1) * 128 + 64 + l]) + (part[(t * 4 + 2) * 128 + 64 + l] + part[(t * 4 + 3) * 128 + 64 + l]);
      const float ss = wave_sum(o0 * o0 + o1 * o1); const float rs = 1.0f / sqrtf(ss * (1.f / 128.f) + LN_EPS);
      const size_t gi = (size_t)(row0 + t) * 512 + h * 128; bf16* mo = MIX + (size_t)(row0 + t) * 1024 + h * 128;
      mo[l] = (bf16)f2bf(o0 * rs * norm_g[l] * bf2f(GA[gi + l])); mo[64 + l] = (bf16)f2bf(o1 * rs * norm_g[64 + l] * bf2f(GA[gi + 64 + l])); }
    __syncthreads();
}
constexpr int IX_KST = 144;
constexpr int IX_BUF = 256 * IX_KST;
__device__ __forceinline__ float half_sum(float v) { v += __shfl_xor(v, 1); v += __shfl_xor(v, 2); v += __shfl_xor(v, 4); v += __shfl_xor(v, 8); v += __shfl_xor(v, 16); return v; }
__device__ __forceinline__ int half_sumi(int v) { v += __shfl_xor(v, 1); v += __shfl_xor(v, 2); v += __shfl_xor(v, 4); v += __shfl_xor(v, 8); v += __shfl_xor(v, 16); return v; }

__device__ __forceinline__ void indexer_prompt_unit(LAS unsigned char* L, unsigned char* ws, int b, int u, int tid) {
    const int lane = tid & 63, wave = __builtin_amdgcn_readfirstlane(tid >> 6), r32 = lane & 31, hh = lane >> 5;
    const bf16* QI = (const bf16*)(ws + WS_QI); const bf16* KI = (const bf16*)(ws + WS_KI); const float* WI = (const float*)(ws + WS_WI); unsigned* MASK = (unsigned*)(ws + WS_MASK);
    const int t0 = 16 * u, NKT = (u >> 1) + 1;
    const int tq = t0 + 2 * wave + hh;
    bf16x8 afr[4]; { const int tok = t0 + 2 * wave + ((r32 >> 2) & 1), head = (r32 & 3) + 4 * (r32 >> 3); const bf16* qp = QI + (size_t)(b * SEQ + tok) * 1024 + head * 64 + 8 * hh;
#pragma unroll
        for (int ks = 0; ks < 4; ++ks) afr[ks] = *(const bf16x8*)(qp + 16 * ks); }
    float wv[16]; { const f32x4* wp = (const f32x4*)(WI + (size_t)(b * SEQ + tq) * 16);
#pragma unroll
        for (int i = 0; i < 4; ++i) { const f32x4 x = wp[i]; wv[4 * i] = x[0]; wv[4 * i + 1] = x[1]; wv[4 * i + 2] = x[2]; wv[4 * i + 3] = x[3]; } }
    float sc[64];
#pragma unroll
    for (int j = 0; j < 64; ++j) sc[j] = -__builtin_inff();
    float ssum = 0.f, ssq = 0.f;
    const char* kbase = (const char*)(KI + (size_t)b * SEQ * 64);
    v4u stg[4];
#pragma unroll
    for (int i = 0; i < 4; ++i) { const int q = tid + 512 * i; stg[i] = *(const v4u*)(kbase + (size_t)(q >> 3) * 128 + (q & 7) * 16); }
#pragma unroll
    for (int i = 0; i < 4; ++i) { const int q = tid + 512 * i; *(LAS v4u*)(L + (q >> 3) * IX_KST + (q & 7) * 16) = stg[i]; }
    __syncthreads();
#pragma unroll
    for (int c = 0; c < 8; ++c) {
        if (8 * c < NKT) {
            const bool more = 8 * (c + 1) < NKT;
            if (more) {
#pragma unroll
                for (int i = 0; i < 4; ++i) { const int q = tid + 512 * i; stg[i] = *(const v4u*)(kbase + (size_t)(256 * (c + 1) + (q >> 3)) * 128 + (q & 7) * 16); } }
            const LAS unsigned char* kb = L + (c & 1) * IX_BUF;
#pragma unroll
            for (int jj = 0; jj < 8; ++jj) {
                const int j = 8 * c + jj;
                if (j < NKT) {
                    f32x16 acc = {};
#pragma unroll
                    for (int ks = 0; ks < 4; ++ks) acc = __builtin_amdgcn_mfma_f32_32x32x16_bf16(afr[ks], *(const LAS bf16x8*)(kb + (32 * jj + r32) * IX_KST + (16 * ks + 8 * hh) * 2), acc, 0, 0, 0);
                    float I = 0.f;
#pragma unroll
                    for (int r = 0; r < 16; ++r) I += wv[r] * __builtin_amdgcn_fmed3f(acc[r], 0.f, __builtin_inff());
                    const bool valid = (32 * j + r32) <= tq;
                    sc[j] = valid ? I : -__builtin_inff(); const float Iv = valid ? I : 0.f; ssum += Iv; ssq += Iv * Iv;
                    asm volatile("" : "+v"(sc[j]), "+v"(ssum), "+v"(ssq) :: "memory");
                }
            }
            if (more) {
#pragma unroll
                for (int i = 0; i < 4; ++i) { const int q = tid + 512 * i; *(LAS v4u*)(L + ((c + 1) & 1) * IX_BUF + (q >> 3) * IX_KST + (q & 7) * 16) = stg[i]; } }
            __syncthreads();
        }
    }
    float tau = -3.0e38f;
    if (u >= 16) {
        const float n = (float)(tq + 1);
        const float mu = half_sum(ssum) / n; const float var = fmaxf(half_sum(ssq) / n - mu * mu, 1e-30f); const float sd = sqrtf(var);
        const float p = 256.f / n; const float z = logf((1.f - p) / p) * (1.f / 1.702f);
        float lo = 0.f, hi = 0.f, clo = 0.f, chi = 0.f; bool hlo = false, hhi = false, done = false;
        float cand = mu + z * sd; float step = 0.25f * sd;
        for (int it = 0; it < 64; ++it) {
            int cnt = 0;
#pragma unroll
            for (int g = 0; g < 8; ++g) if (8 * g < NKT) {
#pragma unroll
                for (int jj = 0; jj < 8; ++jj) cnt += (sc[8 * g + jj] >= cand) ? 1 : 0; }
            const float C = (float)half_sumi(cnt);
            if (!done) {
                if (C == 256.f) { tau = cand; done = true; }
                else {
                    if (C > 256.f) { lo = cand; clo = C; hlo = true; } else { hi = cand; chi = C; hhi = true; }
                    float nx;
                    if (hlo && hhi) {
                        float fr = (clo - 256.f) / (clo - chi); fr = fminf(fmaxf(fr, 0.02f), 0.98f); if ((it & 3) == 3) fr = 0.5f;
                        nx = lo + (hi - lo) * fr;
                        if (!(nx > lo) || !(nx < hi)) { nx = 0.5f * lo + 0.5f * hi; if (!(nx > lo) || !(nx < hi)) { tau = lo; done = true; } }
                    } else { nx = (C > 256.f) ? cand + step : cand - step; step *= 2.f; }
                    cand = nx;
                }
            }
            if (!__any(!done)) break;
        }
        if (!done) tau = hlo ? lo : -3.0e38f;
    }
    unsigned mw0 = 0u, mw1 = 0u;
#pragma unroll
    for (int j = 0; j < 64; ++j) if (j < NKT) { const unsigned long long m = __ballot(sc[j] >= tau); const unsigned m_lo = (unsigned)m, m_hi = (unsigned)(m >> 32);
        mw0 = (lane == j) ? m_lo : mw0; mw1 = (lane == j) ? m_hi : mw1; }
    unsigned* mr = MASK + (size_t)(b * SEQ + t0 + 2 * wave) * 64 + lane; mr[0] = mw0; mr[64] = mw1;
    __syncthreads();
}
__device__ __forceinline__ void sample_scores_unit(LAS unsigned char* L, unsigned char* ws, const float* cache_kidx, const int* page_table, int b, int pg, int tid) {
    const int lane = tid & 63, wave = __builtin_amdgcn_readfirstlane(tid >> 6), r32 = lane & 31, hh = lane >> 5, a = wave & 3, kh = wave >> 2;
    const bf16* QI = (const bf16*)(ws + WS_QI); const float* WI = (const float*)(ws + WS_WI); float* SC = (float*)(ws + WS_SCORES);
    bf16x8 afr[4]; { const int tok = 2 * a + ((r32 >> 2) & 1), head = (r32 & 3) + 4 * (r32 >> 3); const bf16* qp = QI + (size_t)(MP + b * 8 + tok) * 1024 + head * 64 + 8 * hh;
#pragma unroll
        for (int ks = 0; ks < 4; ++ks) afr[ks] = *(const bf16x8*)(qp + 16 * ks); }
    float wv[16]; { const f32x4* wp = (const f32x4*)(WI + (size_t)(MP + b * 8 + 2 * a + hh) * 16);
#pragma unroll
        for (int i = 0; i < 4; ++i) { const f32x4 x = wp[i]; wv[4 * i] = x[0]; wv[4 * i + 1] = x[1]; wv[4 * i + 2] = x[2]; wv[4 * i + 3] = x[3]; } }
    f32x4 stg[8];
#define SS_LOAD(st) do { _Pragma("unroll") for (int i = 0; i < 4; ++i) { const int q = tid + 512 * i, key = q >> 3; const int phys = page_table[b * NPAGES + 8 * pg + 2 * (st) + (key >> 7)]; \
        const float* src = cache_kidx + ((size_t)phys * PAGE + (key & 127)) * 64 + 8 * (q & 7); stg[2 * i] = *(const f32x4*)src; stg[2 * i + 1] = *(const f32x4*)(src + 4); } } while (0)
#define SS_STORE(buf) do { _Pragma("unroll") for (int i = 0; i < 4; ++i) { const int q = tid + 512 * i; v4u o; o.x = pk2(stg[2 * i][0], stg[2 * i][1]); o.y = pk2(stg[2 * i][2], stg[2 * i][3]); o.z = pk2(stg[2 * i + 1][0], stg[2 * i + 1][1]); o.w = pk2(stg[2 * i + 1][2], stg[2 * i + 1][3]); \
        *(LAS v4u*)(L + (buf) * IX_BUF + (q >> 3) * IX_KST + (q & 7) * 16) = o; } } while (0)
    SS_LOAD(0); SS_STORE(0);
    __syncthreads();
#pragma unroll
    for (int st = 0; st < 4; ++st) {
        if (st < 3) SS_LOAD(st + 1);
        const LAS unsigned char* kb = L + (st & 1) * IX_BUF;
#pragma unroll
        for (int jj = 0; jj < 4; ++jj) { const int j = kh * 4 + jj; f32x16 acc = {};
#pragma unroll
            for (int ks = 0; ks < 4; ++ks) acc = __builtin_amdgcn_mfma_f32_32x32x16_bf16(afr[ks], *(const LAS bf16x8*)(kb + (32 * j + r32) * IX_KST + (16 * ks + 8 * hh) * 2), acc, 0, 0, 0);
            float I = 0.f;
#pragma unroll
            for (int r = 0; r < 16; ++r) I += wv[r] * __builtin_amdgcn_fmed3f(acc[r], 0.f, __builtin_inff());
            asm volatile("" : "+v"(I) :: "memory");
            SC[(size_t)(b * 8 + 2 * a + hh) * SC_LD + 1024 * pg + 256 * st + 32 * j + r32] = I; }
        if (st < 3) SS_STORE((st + 1) & 1);
        __syncthreads();
    }
#undef SS_LOAD
#undef SS_STORE
}

__device__ __forceinline__ float wave_max(float v) {
#pragma unroll
    for (int o = 1; o < 64; o <<= 1) v = fmaxf(v, __shfl_xor(v, o));
    return v;
}
constexpr int SG_RED = 0  , SG_NSC = 256  , SG_WPFX = 320  , SG_SEL = 512  , SG_LG = 2048  , SG_ACC = 12288  , SG_END = 12288 + 16384;

__device__ __forceinline__ void sample_select_gather_unit(LAS unsigned char* L, unsigned char* ws, const float* out, const float* cache_k, const float* cache_v, const int* page_table, int b, int t, int tid) {
    const int lane = tid & 63, wave = __builtin_amdgcn_readfirstlane(tid >> 6);
    const bf16* QI = (const bf16*)(ws + WS_QI); const bf16* KI = (const bf16*)(ws + WS_KI); const float* WI = (const float*)(ws + WS_WI); const float* SC = (const float*)(ws + WS_SCORES);
    const bf16* QB = (const bf16*)(ws + WS_QB); const bf16* GB = (const bf16*)(ws + WS_GB); bf16* MIX = (bf16*)(ws + WS_MIX);
    const int row = MP + b * 8 + t;
    LAS float* red = (LAS float*)(L + SG_RED); LAS float* nsc = (LAS float*)(L + SG_NSC); LAS int* wpfx = (LAS int*)(L + SG_WPFX); LAS int* sel = (LAS int*)(L + SG_SEL);
    LAS float* lg = (LAS float*)(L + SG_LG); LAS float* accb = (LAS float*)(L + SG_ACC);
    { const int j = wave, h = lane >> 2, part = lane & 3; const bf16* qp = QI + (size_t)row * 1024 + h * 64 + 16 * part; const bf16* kp = KI + (size_t)(MP + b * 8 + j) * 64 + 16 * part;
      const v4u q0 = *(const v4u*)qp, q1 = *(const v4u*)(qp + 8), k0 = *(const v4u*)kp, k1 = *(const v4u*)(kp + 8);
      const unsigned qa[8] = {q0.x, q0.y, q0.z, q0.w, q1.x, q1.y, q1.z, q1.w}, ka[8] = {k0.x, k0.y, k0.z, k0.w, k1.x, k1.y, k1.z, k1.w}; float d = 0.f;
#pragma unroll
      for (int i = 0; i < 8; ++i) { d += __builtin_bit_cast(float, qa[i] << 16) * __builtin_bit_cast(float, ka[i] << 16); d += __builtin_bit_cast(float, qa[i] & 0xffff0000u) * __builtin_bit_cast(float, ka[i] & 0xffff0000u); }
      d += __shfl_xor(d, 1); d += __shfl_xor(d, 2);
      float s = WI[(size_t)row * 16 + h] * fmaxf(d, 0.f);
      s += __shfl_xor(s, 4); s += __shfl_xor(s, 8); s += __shfl_xor(s, 16); s += __shfl_xor(s, 32);
      if (lane == 0) nsc[j] = (j <= t) ? s : -__builtin_inff(); }
    float sv[17];
#pragma unroll
    for (int i = 0; i < 16; ++i) sv[i] = SC[(size_t)(b * 8 + t) * SC_LD + tid + 512 * i];
    __syncthreads();
    sv[16] = tid < 8 ? nsc[tid] : -__builtin_inff();
    float tau;
    { float s1 = 0.f, s2 = 0.f;
#pragma unroll
      for (int i = 0; i < 17; ++i) { const float v = (sv[i] > -3.0e38f) ? sv[i] : 0.f; s1 += v; s2 += v * v; }
      s1 = wave_sum(s1); s2 = wave_sum(s2);
      if (lane == 0) { red[wave * 2] = s1; red[wave * 2 + 1] = s2; }
      __syncthreads();
      float a1 = 0.f, a2 = 0.f;
#pragma unroll
      for (int w = 0; w < 8; ++w) { a1 += red[w * 2]; a2 += red[w * 2 + 1]; }
      const float n = (float)(PAST + t + 1); const float mu = a1 / n; const float sd = sqrtf(fmaxf(a2 / n - mu * mu, 1e-30f));
      const float p = 256.f / n; const float z = logf((1.f - p) / p) * (1.f / 1.702f);
      float lo = 0.f, hi = 0.f, clo = 0.f, chi = 0.f; bool hlo = false, hhi = false, done = false; float cand = mu + z * sd, step = 0.25f * sd; tau = -3.0e38f;
      for (int it = 0; it < 64 && !done; ++it) {
          int cnt = 0;
#pragma unroll
          for (int i = 0; i < 17; ++i) cnt += (sv[i] >= cand) ? 1 : 0;
          float cf = wave_sum((float)cnt);
          LAS float* rb = red + 16 + (it & 1) * 8;
          if (lane == 0) rb[wave] = cf;
          __syncthreads();
          float C = 0.f;
#pragma unroll
          for (int w = 0; w < 8; ++w) C += rb[w];
          if (C == 256.f) { tau = cand; done = true; }
          else {
              if (C > 256.f) { lo = cand; clo = C; hlo = true; } else { hi = cand; chi = C; hhi = true; }
              float nx;
              if (hlo && hhi) { float fr = (clo - 256.f) / (clo - chi); fr = fminf(fmaxf(fr, 0.02f), 0.98f); if ((it & 3) == 3) fr = 0.5f; nx = lo + (hi - lo) * fr;
                  if (!(nx > lo) || !(nx < hi)) { nx = 0.5f * lo + 0.5f * hi; if (!(nx > lo) || !(nx < hi)) { tau = lo; done = true; } } }
              else { nx = (C > 256.f) ? cand + step : cand - step; step *= 2.f; }
              cand = nx; }
      }
      if (!done) tau = hlo ? lo : -3.0e38f; }
    { int c = 0;
#pragma unroll
      for (int i = 0; i < 17; ++i) c += (sv[i] >= tau) ? 1 : 0;
      int inc = c;
#pragma unroll
      for (int o = 1; o < 64; o <<= 1) { const int x = __shfl_up(inc, o); if (lane >= o) inc += x; }
      if (lane == 63) wpfx[wave] = inc;
      if (tid < 256) sel[tid] = -1;
      __syncthreads();
      int base = inc - c;
#pragma unroll
      for (int w = 0; w < 8; ++w) if (w < wave) base += wpfx[w];
#pragma unroll
      for (int i = 0; i < 17; ++i) if (sv[i] >= tau) { if (base < 256) sel[base] = (i < 16) ? tid + 512 * i : PAST + tid; ++base; }
      __syncthreads(); }
    float qf[8]; { const v4u qv = *(const v4u*)(QB + (size_t)row * 512 + 8 * lane); const unsigned qa[4] = {qv.x, qv.y, qv.z, qv.w};
#pragma unroll
        for (int i = 0; i < 4; ++i) { qf[2 * i] = __builtin_bit_cast(float, qa[i] << 16); qf[2 * i + 1] = __builtin_bit_cast(float, qa[i] & 0xffff0000u); } }
    const float* newk = out + O_KS + (size_t)(b * 8) * 512; const float* newv = out + O_VS + (size_t)(b * 8) * 512;
#pragma unroll 4
    for (int kk = 0; kk < 32; ++kk) { const int slot = wave * 32 + kk; const int idx = sel[slot]; float d = 0.f;
        if (idx >= 0) { const float* kr = idx < PAST ? cache_k + ((size_t)page_table[b * NPAGES + (idx >> 7)] * PAGE + (idx & 127)) * 512 : newk + (size_t)(idx - PAST) * 512;
            const f32x4 k0 = *(const f32x4*)(kr + 8 * lane), k1 = *(const f32x4*)(kr + 8 * lane + 4);
            d = (qf[0] * k0[0] + qf[1] * k0[1]) + (qf[2] * k0[2] + qf[3] * k0[3]) + (qf[4] * k1[0] + qf[5] * k1[1]) + (qf[6] * k1[2] + qf[7] * k1[3]); }
        d += __shfl_xor(d, 1); d += __shfl_xor(d, 2); d += __shfl_xor(d, 4);
        if ((lane & 7) == 0) lg[slot * 8 + (lane >> 3)] = idx >= 0 ? d : -__builtin_inff(); }
    __syncthreads();
    { const int h = wave; float x[4]; float m = -__builtin_inff();
#pragma unroll
      for (int i = 0; i < 4; ++i) { x[i] = lg[(lane + 64 * i) * 8 + h]; m = fmaxf(m, x[i]); }
      m = wave_max(m); float s = 0.f;
#pragma unroll
      for (int i = 0; i < 4; ++i) { x[i] = ex2(x[i] - m); s += x[i]; }
      s = wave_sum(s); const float rs = 1.0f / s;
#pragma unroll
      for (int i = 0; i < 4; ++i) lg[(lane + 64 * i) * 8 + h] = x[i] * rs; }
    __syncthreads();
    float acc[8] = {0.f, 0.f, 0.f, 0.f, 0.f, 0.f, 0.f, 0.f};
#pragma unroll 4
    for (int kk = 0; kk < 32; ++kk) { const int slot = wave * 32 + kk; const int idx = sel[slot];
        if (idx >= 0) { const float* vr = idx < PAST ? cache_v + ((size_t)page_table[b * NPAGES + (idx >> 7)] * PAGE + (idx & 127)) * 512 : newv + (size_t)(idx - PAST) * 512;
            const f32x4 v0 = *(const f32x4*)(vr + 8 * lane), v1 = *(const f32x4*)(vr + 8 * lane + 4); const float p = lg[slot * 8 + (lane >> 3)];
            acc[0] += p * v0[0]; acc[1] += p * v0[1]; acc[2] += p * v0[2]; acc[3] += p * v0[3]; acc[4] += p * v1[0]; acc[5] += p * v1[1]; acc[6] += p * v1[2]; acc[7] += p * v1[3]; } }
    *(LAS f32x4*)(accb + wave * 512 + 8 * lane) = (f32x4){acc[0], acc[1], acc[2], acc[3]}; *(LAS f32x4*)(accb + wave * 512 + 8 * lane + 4) = (f32x4){acc[4], acc[5], acc[6], acc[7]};
    __syncthreads();
    { float o = 0.f;
#pragma unroll
      for (int w = 0; w < 8; ++w) o += accb[w * 512 + tid];
      MIX[(size_t)row * 1024 + 512 + tid] = (bf16)f2bf(o * bf2f(GB[(size_t)row * 512 + tid])); }
    __syncthreads();
}
struct Args { const float* in[15]; float* out; unsigned char* ws; };

__device__ __forceinline__ void p0_transpose_item(const float* W, int K, int N, bf16* WT, int drow, int scol, int valid, int k0, LAS float* scr, int lane) {
#pragma unroll 8
    for (int i = 0; i < 32; ++i) { const int kk = 2 * i + (lane >> 5); scr[kk * 33 + (lane & 31)] = ((lane & 31) < valid) ? W[(size_t)(k0 + kk) * N + scol + (lane & 31)] : 0.f; }
    LDS_WAIT(); asm volatile("" ::: "memory");
    const int c = lane & 7;
#pragma unroll
    for (int j = 0; j < 4; ++j) { const int n = (lane >> 3) + 8 * j; const LAS float* s = scr + (8 * c) * 33 + n;
        v4u o; o.x = pk2(s[0 * 33], s[1 * 33]); o.y = pk2(s[2 * 33], s[3 * 33]); o.z = pk2(s[4 * 33], s[5 * 33]); o.w = pk2(s[6 * 33], s[7 * 33]);
        *(GAS v4u*)(WT + (size_t)(drow + n) * K + k0 + 8 * c) = o; }
    LDS_WAIT(); asm volatile("" ::: "memory");
}

__device__ __forceinline__ float rope_inv(int j) {
    return j == 0 ? 1.0f : j == 1 ? 0.1939227432012558f : j == 2 ? 0.03760603070259094f : j == 3 ? 0.007292664609849453f : j == 4 ? 0.0014142135623842478f : j == 5 ? 0.00027424818836152554f : j == 6 ? 5.3182957344688475e-05f : 1.0313385246263351e-05f; }
__device__ __forceinline__ void sincos_acc(float angf, float& cs, float& sn) {
    const double x = (double)angf; const double kq = __builtin_rint(x * 0.63661977236758134308);
    const double r = (x - kq * 1.57079632679489655800e+00) - kq * 6.12323399573676603587e-17; const double r2 = r * r;
    double s = -1.0 / 1307674368000.0; s = s * r2 + 1.0 / 6227020800.0; s = s * r2 - 1.0 / 39916800.0; s = s * r2 + 1.0 / 362880.0; s = s * r2 - 1.0 / 5040.0; s = s * r2 + 1.0 / 120.0; s = s * r2 - 1.0 / 6.0; s = s * r2 * r + r;
    double c = 1.0 / 87178291200.0; c = c * r2 - 1.0 / 479001600.0; c = c * r2 + 1.0 / 3628800.0; c = c * r2 - 1.0 / 40320.0; c = c * r2 + 1.0 / 720.0; c = c * r2 - 1.0 / 24.0; c = c * r2 + 0.5; c = 1.0 - c * r2;
    const int q = ((int)kq) & 3;
    const double cc = (q == 0) ? c : (q == 1) ? -s : (q == 2) ? -c : s; const double ss = (q == 0) ? s : (q == 1) ? c : (q == 2) ? -s : -c;
    cs = (float)cc; sn = (float)ss; }

typedef const __attribute__((address_space(4))) Args* kargp_t;
__device__ __forceinline__ kargp_t kargs() { kargp_t p = (kargp_t)__builtin_amdgcn_kernarg_segment_ptr(); asm volatile("" : "+s"(p)); return p; }
__device__ __forceinline__ int opaque_tid() { int t = threadIdx.x; asm volatile("" : "+v"(t)); return t; }

__global__ void __launch_bounds__(NTHR, 2) hymba_fwd(Args args_unused) {
    extern __shared__ __attribute__((aligned(16))) unsigned char lds[];
    LAS unsigned char* L = (LAS unsigned char*)lds;
    XcdBarrier bar;
    {
        volatile LAS unsigned* MISC = (volatile LAS unsigned*)(L + MISC_OFF);
        const int tid = opaque_tid();
        if (tid < 64) MISC[tid] = 0u;
        __syncthreads();
        bar = xcd_barrier_post((unsigned*)((gu32*)(kargs()->ws + WS_CTL) + CW_BAR), MISC + 8);
    }

    {
        kargp_t A = kargs(); unsigned char* ws = A->ws; const float* x_p = A->in[0]; const float* x_s = A->in[1]; const float* w_in = A->in[7]; const float* lb_logits = A->in[8]; const float* w_out = A->in[12];
        bf16* WINT = (bf16*)(ws + WS_WINT); bf16* WOUTT = (bf16*)(ws + WS_WOUTT); float* ROPE = (float*)(ws + WS_ROPE); float* LBV = (float*)(ws + WS_LBV); bf16* XB = (bf16*)(ws + WS_XB);
        const int tid = opaque_tid(), lane = tid & 63, wave = __builtin_amdgcn_readfirstlane(tid >> 6); const int G = gridDim.x, bid = blockIdx.x;
        LAS float* scr = (LAS float*)(L + wave * 16384);
        const int gw = bid * NWAVES + wave, NGW = G * NWAVES;
        constexpr int I_IN = 16 * 168, I_OUT = 16 * 32;
        for (int it = gw; it < I_IN + I_OUT; it += NGW) {
            if (it < I_IN) {
                const int kb = it / 168, nb = it % 168; int scol = 32 * nb, valid = 32;
                if (nb >= 160) { const int j = nb - 160; if (j == 0) { scol = 5120; } else if (j == 1) { scol = 5184; valid = 16; } else if (j == 4) { scol = 5152; } else { scol = 0; valid = 0; } }
                p0_transpose_item(w_in, DM, DIN, WINT, 32 * nb, scol, valid, 64 * kb, scr, lane);
            } else { const int r = it - I_IN, kb = r / 32, nb = r % 32; p0_transpose_item(w_out, DM, DM, WOUTT, 32 * nb, 32 * nb, 32, 64 * kb, scr, lane); }
        }
        const size_t gt = (size_t)bid * NTHR + tid, NGT = (size_t)G * NTHR;
        for (size_t i = gt; i < (size_t)M * DM / 8; i += NGT) {
            const size_t e = i * 8; const float* src = e < (size_t)MP * DM ? x_p + e : x_s + (e - (size_t)MP * DM);
            const f32x4 a = *(const f32x4*)src, b = *(const f32x4*)(src + 4);
            v4u o; o.x = pk2(a[0], a[1]); o.y = pk2(a[2], a[3]); o.z = pk2(b[0], b[1]); o.w = pk2(b[2], b[3]);
            *(GAS v4u*)(XB + e) = o;
        }
        for (size_t i = gt; i < 2056 * 8; i += NGT) {
            const int p = (int)(i >> 3), j = (int)(i & 7); const int pos = p < 2048 ? p : PAST + (p - 2048);
            const float inv = rope_inv(j); const float ang = (float)pos * inv;
            float cs, sn; sincos_acc(ang, cs, sn); ROPE[2 * i] = cs; ROPE[2 * i + 1] = sn;
        }
        for (size_t i = gt; i < 512; i += NGT) { const float l0 = lb_logits[i], l1 = lb_logits[512 + i]; LBV[i] = 1.0f / (1.0f + expf(l1 - l0)); }
    }
    xcd_barrier(bar);

    {
        kargp_t A = kargs(); unsigned char* ws = A->ws; const int G = gridDim.x, bid = blockIdx.x;
        pg8::Gemm g{(const bf16*)(ws + WS_XB), (const bf16*)(ws + WS_WINT), M, NPAD, DM}; pg8::StaticOrder S; S.init(M, NPAD, G, bid);
        pg8::EpiIn E; E.ws = ws; E.out = A->out; E.kn_g = A->in[10]; E.kn_b = A->in[11];
        pg8::gemm_phase<pg8::EpiIn, pg8::StaticOrder, true, true>(L, g, S, E);
    }
    xcd_barrier(bar);

    {
        kargp_t A = kargs(); unsigned char* ws = A->ws; const int tid = opaque_tid(); const int G = gridDim.x, bid = blockIdx.x;
        for (int u = bid; u < 256; u += G) hgrn_prompt_unit<false>(L, ws, A->out, A->in[9], u, tid);
        for (int u = bid; u < 128; u += G) hgrn_sample_unit(L, ws, A->out, A->in[5], A->in[9], u, tid);
    }
    {
        kargp_t A = kargs(); unsigned char* ws = A->ws; const int tid = opaque_tid(); const int G = gridDim.x, bid = blockIdx.x;
        for (int p = bid; p < 1024; p += G) { const int b = (p & 511) >> 6, j = p & 63; indexer_prompt_unit(L, ws, b, p < 512 ? 127 - j : j, tid); }
    }
    {
        kargp_t A = kargs(); unsigned char* ws = A->ws; const int tid = opaque_tid(); const int G = gridDim.x, bid = blockIdx.x;
        for (int u = bid; u < 256; u += G) sample_scores_unit(L, ws, A->in[4], (const int*)A->in[6], u >> 3, u & 7, tid);
    }
    xcd_barrier(bar);

    {
        kargp_t A = kargs(); unsigned char* ws = A->ws; const int tid = opaque_tid(); const int G = gridDim.x, bid = blockIdx.x;
        for (int u = bid; u < 256; u += G) hgrn_prompt_unit<true>(L, ws, A->out, A->in[9], u, tid);
    }
    {
        kargp_t A = kargs(); unsigned char* ws = A->ws; const int tid = opaque_tid(); const int G = gridDim.x, bid = blockIdx.x;
        for (int u = bid; u < 256; u += G) sample_select_gather_unit(L, ws, A->out, A->in[2], A->in[3], (const int*)A->in[6], u >> 3, u & 7, tid);
    }
    {
        kargp_t A = kargs(); unsigned char* ws = A->ws; const int G = gridDim.x, bid = blockIdx.x;
        const int vcu = (G % 8 == 0) ? (bid % 8) * (G / 8) + bid / 8 : bid;
        for (int p = vcu; p < 512; p += G) { const int bh = (p & 255) >> 2, s = p & 3; const int qb = p < 256 ? 7 - s : s;
            attn_body::attn_unit<8>(bh >> 3, bh & 7, qb, (const attn_body::bf16*)(ws + WS_QB), (const attn_body::bf16*)(ws + WS_KB), (const attn_body::bf16*)(ws + WS_VB), (const unsigned*)(ws + WS_MASK), (const unsigned short*)(ws + WS_GB), (unsigned short*)(ws + WS_MIX), (char*)lds); }
    }
    xcd_barrier(bar);

    {
        kargp_t A = kargs(); unsigned char* ws = A->ws; const int G = gridDim.x, bid = blockIdx.x;
        pg8::Gemm g{(const bf16*)(ws + WS_MIX), (const bf16*)(ws + WS_WOUTT), M, DM, DM}; pg8::StaticOrder S; S.init(M, DM, G, bid);
        pg8::EpiF32 E{(float*)(ws + WS_Y), DM};
        pg8::gemm_phase<pg8::EpiF32, pg8::StaticOrder, true, true>(L, g, S, E);
    }
    xcd_barrier(bar);

    {
        kargp_t A = kargs(); unsigned char* ws = A->ws; const float* x_p = A->in[0]; const float* x_s = A->in[1]; float* out = A->out;
        const int tid = opaque_tid(), lane = tid & 63, wave = __builtin_amdgcn_readfirstlane(tid >> 6); const int G = gridDim.x, bid = blockIdx.x;
        const float* ln_g = A->in[13]; const float* ln_b = A->in[14]; const float* Y = (const float*)(ws + WS_Y);
        const int gw = bid * NWAVES + wave, NGW = G * NWAVES;
        for (int m = gw; m < M; m += NGW) {
            const float* xr = m < MP ? x_p + (size_t)m * DM : x_s + (size_t)(m - MP) * DM; float* orow = out + (m < MP ? O_YP + (size_t)m * DM : O_YS + (size_t)(m - MP) * DM);
            f32x4 v[4]; float sm = 0.f;
#pragma unroll
            for (int j = 0; j < 4; ++j) { const f32x4 a = *(const f32x4*)(xr + 256 * j + 4 * lane), y = *(const f32x4*)(Y + (size_t)m * DM + 256 * j + 4 * lane); v[j] = a * ALPHA + y; sm += (v[j][0] + v[j][1]) + (v[j][2] + v[j][3]); }
            const float mean = wave_sum(sm) * (1.f / DM); float s2 = 0.f;
#pragma unroll
            for (int j = 0; j < 4; ++j) { v[j] = v[j] - mean; s2 += (v[j][0] * v[j][0] + v[j][1] * v[j][1]) + (v[j][2] * v[j][2] + v[j][3] * v[j][3]); }
            const float rstd = 1.f / sqrtf(wave_sum(s2) * (1.f / DM) + LN_EPS);
#pragma unroll
            for (int j = 0; j < 4; ++j) { const f32x4 gg = *(const f32x4*)(ln_g + 256 * j + 4 * lane), bb = *(const f32x4*)(ln_b + 256 * j + 4 * lane); *(f32x4*)(orow + 256 * j + 4 * lane) = v[j] * rstd * gg + bb; }
        }
    }
}

extern "C" void kernel_launch(void* const* d_in, const int* in_sizes, int n_in, void* d_out, int out_size, void* d_ws, size_t ws_size, hipStream_t stream) {
    static int grid = 0;
    if (grid == 0) {
        if (n_in != 15 || (size_t)out_size != O_END || ws_size < WS_END) { fprintf(stderr, "kernel_launch: unexpected shapes (n_in %d out %d ws %zu)\n", n_in, out_size, ws_size); grid = -1; return; }
        int dev = 0, cus = 0, per_cu = 0;
        if (hipGetDevice(&dev) != hipSuccess || hipDeviceGetAttribute(&cus, hipDeviceAttributeMultiprocessorCount, dev) != hipSuccess) { grid = -1; return; }
        if (hipFuncSetAttribute((const void*)hymba_fwd, hipFuncAttributeMaxDynamicSharedMemorySize, LDS_BYTES) != hipSuccess) { fprintf(stderr, "kernel_launch: hipFuncSetAttribute failed\n"); grid = -1; return; }
        if (hipOccupancyMaxActiveBlocksPerMultiprocessor(&per_cu, (const void*)hymba_fwd, NTHR, LDS_BYTES) != hipSuccess || per_cu < 1) fprintf(stderr, "kernel_launch: occupancy query reports %d\n", per_cu);
        (void)hipGetLastError();
        grid = cus;
    }
    if (grid < 0) return;
    if (hipMemsetAsync((char*)d_ws + WS_CTL, 0, CTL_ZERO_BYTES, stream) != hipSuccess) return;
    Args a{};
    for (int i = 0; i < 15; ++i) a.in[i] = (const float*)d_in[i];
    a.out = (float*)d_out; a.ws = (unsigned char*)d_ws;
    hipLaunchKernelGGL(hymba_fwd, dim3(grid), dim3(NTHR), LDS_BYTES, stream, a);
}
```

```cpp
#include <hip/hip_runtime.h>
#include <cstdio>
#include <cstdint>
constexpr int NWAVES = 8, NTHR = NWAVES * 64;
constexpr int DM = 1024, NB = 8, SEQ = 2048, DB = 32, DT = 8, PAST = 8192, PAGE = 128, NPAGES = 64;
constexpr int MP = NB * SEQ, MS = DB * DT, M = MP + MS;
constexpr int DIN = 5200, NPAD = 5376;
constexpr int AH = 4, ADK = 128, ADV = 128, BH = 8, BDH = 64, IH = 16, IDD = 64, TOPK = 256;
constexpr float LN_EPS = 1e-5f;
constexpr float ALPHA = 1.189207115002721f;
constexpr float C2 = 0.125f * 1.4426950408889634f;
constexpr size_t O_YP = 0, O_YS = O_YP + (size_t)MP * DM, O_KP = O_YS + (size_t)MS * DM, O_VP = O_KP + (size_t)MP * 512, O_KIP = O_VP + (size_t)MP * 512,
                 O_SP = O_KIP + (size_t)MP * 64, O_KS = O_SP + (size_t)NB * AH * ADK * ADV, O_VS = O_KS + (size_t)MS * 512, O_KIS = O_VS + (size_t)MS * 512,
                 O_SS = O_KIS + (size_t)MS * 64, O_END = O_SS + (size_t)DB * AH * ADK * ADV;
constexpr size_t MiB = 1u << 20;
constexpr size_t WS_CTL = 0, CTL_ZERO_BYTES = 1 * MiB;
constexpr size_t WS_WINT = 2 * MiB, WS_WOUTT = 13 * MiB, WS_ROPE = 15 * MiB, WS_LBV = 15 * MiB + 512 * 1024, WS_XB = 16 * MiB;
constexpr size_t WS_QA = 49 * MiB, WS_VA = 66 * MiB, WS_GA = 83 * MiB, WS_QB = 100 * MiB, WS_KB = 117 * MiB, WS_VB = 134 * MiB, WS_GB = 151 * MiB;
constexpr size_t WS_LOGF = 168 * MiB, WS_QI = 201 * MiB, WS_KI = 234 * MiB, WS_WI = 237 * MiB, WS_U = 239 * MiB, WS_ASC = 255 * MiB, WS_MASK = 256 * MiB;
constexpr size_t WS_MIX = 260 * MiB, WS_SCORES = 293 * MiB, WS_Y = 302 * MiB, WS_END = 368 * MiB;
constexpr int SC_LD = 8256;
constexpr int CW_TMO = 0, CW_BAR = 4096;
constexpr int RING_BYTES = 131072;
constexpr int LDS_BYTES = 163840;
constexpr int MISC_OFF = LDS_BYTES - 256;

namespace pg8 {
#define PG8_LAS __attribute__((address_space(3)))
typedef unsigned short bf16_t;
typedef short bf16x8 __attribute__((ext_vector_type(8)));
typedef float f32x4 __attribute__((ext_vector_type(4)));
typedef unsigned u32x4 __attribute__((ext_vector_type(4)));
constexpr int BM = 256, BK = 64, HALF = 128, HTB = HALF * BK * 2  , STAGE_BYTES = 8 * HTB, NXCD = 8, WGM = 8;

__host__ __device__ __forceinline__ int lds_byte(int r, int c) { const int st = (r >> 4) * 2 + (c >> 5), rr = r & 15, cc = c & 31, ob = rr * 64 + cc * 2; return st * 1024 + (ob ^ (((ob >> 9) & 1) << 5)); }
__host__ __device__ __forceinline__ void stage_rc(int b, int& R, int& C) { const int st = b / 1024, sb = b % 1024, swz = sb ^ (((sb >> 9) & 1) << 5); R = (st >> 1) * 16 + swz / 64; C = (st & 1) * 32 + (swz % 64) / 2; }
__host__ __device__ __forceinline__ int perm32(int rho) { const int n = rho >> 4, i = rho & 15; return 8 * (i >> 2) + 4 * n + (i & 3); }

struct Unit { int pm, pn; };
struct Gemm { const bf16_t* A; const bf16_t* Bt; int M, N, K; };

struct StaticOrder {
    int nM, nN, nwg, G, c;
    __host__ __device__ void init(int M, int N, int G_, int c_) { nM = M / BM; nN = N / BM; nwg = nM * nN; G = G_; c = c_; }
    __host__ __device__ bool next(int i, Unit& u) const {
        const long L = (long)i * G + c; if (L >= nwg) return false;
        int wgid = (int)L; { const int q = nwg / NXCD, r = nwg % NXCD, xcd = wgid % NXCD, off = wgid / NXCD; wgid = (xcd < r ? xcd * (q + 1) : r * (q + 1) + (xcd - r) * q) + off; }
        const int nig = WGM * nN, gid = wgid / nig, fm = gid * WGM, gsz = (nM - fm) < WGM ? (nM - fm) : WGM;
        u.pm = fm + ((wgid % nig) % gsz); u.pn = (wgid % nig) / gsz; return true;
    }
    __device__ __forceinline__ void a_ready(const Unit&) const {}
    __device__ __forceinline__ void done(const Unit&) const {}
};

__device__ __forceinline__ unsigned cvt_pk_bf16(float lo, float hi) { unsigned r; asm volatile("v_cvt_pk_bf16_f32 %0, %1, %2" : "=v"(r) : "v"(lo), "v"(hi)); return r; }
typedef float f32x2 __attribute__((ext_vector_type(2)));
__device__ __forceinline__ float sigmoidf_fast(float x) { return __builtin_amdgcn_rcpf(1.0f + __builtin_amdgcn_exp2f(-1.4426950408889634f * x)); }
__device__ __forceinline__ float siluf_fast(float x) { return x * sigmoidf_fast(x); }
__device__ __forceinline__ void st_bf16x8(bf16_t* p, const f32x4 a, const f32x4 b) {
    u32x4 w; w.x = cvt_pk_bf16(a[0], a[1]); w.y = cvt_pk_bf16(a[2], a[3]); w.z = cvt_pk_bf16(b[0], b[1]); w.w = cvt_pk_bf16(b[2], b[3]); *(u32x4*)p = w; }

struct EpiIn {
    static constexpr bool PERM = true, AFTER_DRAIN = false;
    unsigned char* ws; float* out; const float *kn_g, *kn_b;
    static constexpr int MPR = MP;
    static constexpr float c2 = C2;
    __device__ __forceinline__ bf16_t* buf512(int bi) const { return (bf16_t*)(ws + WS_QA + (size_t)bi * (WS_VA - WS_QA)); }
    __device__ __forceinline__ int rope_idx(int row) const { return row < MPR ? (row & 2047) : 2048 + ((row - MPR) & 7); }
    __device__ __forceinline__ void rope8(f32x4& v0, f32x4& v1, int row, int fq) const {
        f32x4 p0, p1;
#pragma unroll
        for (int j = 0; j < 4; ++j) { p0[j] = __shfl_xor(v0[j], 16); p1[j] = __shfl_xor(v1[j], 16); }
        if (fq < 2) {
            const f32x4* t = (const f32x4*)((const float*)(ws + WS_ROPE) + (size_t)rope_idx(row) * 16);
            const f32x4 t0 = t[0], t1 = t[1], t2 = t[2], t3 = t[3];
            const float sg = fq == 0 ? -1.f : 1.f;
            v0[0] = v0[0] * t0[0] + sg * p0[0] * t0[1]; v0[1] = v0[1] * t0[2] + sg * p0[1] * t0[3];
            v0[2] = v0[2] * t1[0] + sg * p0[2] * t1[1]; v0[3] = v0[3] * t1[2] + sg * p0[3] * t1[3];
            v1[0] = v1[0] * t2[0] + sg * p1[0] * t2[1]; v1[1] = v1[1] * t2[2] + sg * p1[1] * t2[3];
            v1[2] = v1[2] * t3[0] + sg * p1[2] * t3[1]; v1[3] = v1[3] * t3[2] + sg * p1[3] * t3[3];
        }
    }
    __device__ __forceinline__ void operator()(const f32x4 (&acc)[2][2][4][2], const Unit& u, int wr, int wc, int fr, int fq) const {
        const int pn = u.pn, row0 = u.pm * BM + wr * 64 + fr, cw = wc * 32 + 8 * fq;
        if (pn < 8) {
            if ((pn >> 1) == 1) {
                const int c0 = (pn & 1) * 256 + cw;
#pragma unroll
                for (int bj = 0; bj < 2; ++bj) { const int c = c0 + bj * HALF; const float* lbv = (const float*)(ws + WS_LBV); const f32x4 l0 = *(const f32x4*)(lbv + c), l1 = *(const f32x4*)(lbv + c + 4);
#pragma unroll
                    for (int ai = 0; ai < 2; ++ai)
#pragma unroll
                        for (int m = 0; m < 4; ++m) { const int row = row0 + ai * HALF + m * 16; f32x4 a = acc[ai][bj][m][0], b = acc[ai][bj][m][1];
#pragma unroll
                            for (int j = 0; j < 4; ++j) { a[j] = 0.6931471805599453f * __builtin_amdgcn_logf(l0[j] + (1.f - l0[j]) * sigmoidf_fast(a[j])); b[j] = 0.6931471805599453f * __builtin_amdgcn_logf(l1[j] + (1.f - l1[j]) * sigmoidf_fast(b[j])); }
                            float* o = (float*)(ws + WS_LOGF) + (size_t)row * 512 + c; *(f32x4*)o = a; *(f32x4*)(o + 4) = b; } }
            } else {
                bf16_t* dst = buf512((pn >> 1) == 0 ? 0 : (pn >> 1) - 1); const bool act = (pn >> 1) != 2;
                const int c0 = (pn & 1) * 256 + cw;
#pragma unroll
                for (int ai = 0; ai < 2; ++ai)
#pragma unroll
                    for (int m = 0; m < 4; ++m) { const int row = row0 + ai * HALF + m * 16;
#pragma unroll
                        for (int bj = 0; bj < 2; ++bj) { f32x4 a = acc[ai][bj][m][0], b = acc[ai][bj][m][1];
                            if (act) {
#pragma unroll
                                for (int j = 0; j < 4; ++j) { a[j] = siluf_fast(a[j]); b[j] = siluf_fast(b[j]); } }
                            st_bf16x8(dst + (size_t)row * 512 + c0 + bj * HALF, a, b); } }
            }
        } else if (pn < 16) {
            const int grp = (pn - 8) >> 1, c0 = (pn & 1) * 256 + cw;
            bf16_t* dst = buf512(3 + grp);
            const bool dorope = (grp < 2) && ((wc & 1) == 0);
#pragma unroll
            for (int ai = 0; ai < 2; ++ai)
#pragma unroll
                for (int m = 0; m < 4; ++m) { const int row = row0 + ai * HALF + m * 16;
#pragma unroll
                    for (int bj = 0; bj < 2; ++bj) { f32x4 a = acc[ai][bj][m][0], b = acc[ai][bj][m][1]; const int c = c0 + bj * HALF;
                        if (dorope) rope8(a, b, row, fq);
                        if (grp == 1 || grp == 2) { float* o = out + (row < MPR ? (grp == 1 ? O_KP : O_VP) + (size_t)row * 512 : (grp == 1 ? O_KS : O_VS) + (size_t)(row - MPR) * 512);
                            *(f32x4*)(o + c) = a; *(f32x4*)(o + c + 4) = b; }
                        if (grp == 0) { a = a * c2; b = b * c2; }
                        if (grp == 3) {
#pragma unroll
                            for (int j = 0; j < 4; ++j) { a[j] = siluf_fast(a[j]); b[j] = siluf_fast(b[j]); } }
                        st_bf16x8(dst + (size_t)row * 512 + c, a, b); } }
        } else if (pn < 20) {
            const int c0 = (pn - 16) * 256 + cw; const bool dorope = (wc & 1) == 0;
#pragma unroll
            for (int ai = 0; ai < 2; ++ai)
#pragma unroll
                for (int m = 0; m < 4; ++m) { const int row = row0 + ai * HALF + m * 16;
#pragma unroll
                    for (int bj = 0; bj < 2; ++bj) { f32x4 a = acc[ai][bj][m][0], b = acc[ai][bj][m][1];
                        if (dorope) rope8(a, b, row, fq);
                        st_bf16x8((bf16_t*)(ws + WS_QI) + (size_t)row * 1024 + c0 + bj * HALF, a, b); } }
        } else {
            if (wc == 0) {
                const f32x4 g00 = *(const f32x4*)(kn_g + 8 * fq), g01 = *(const f32x4*)(kn_g + 8 * fq + 4), g10 = *(const f32x4*)(kn_g + 32 + 8 * fq), g11 = *(const f32x4*)(kn_g + 36 + 8 * fq);
                const f32x4 b00 = *(const f32x4*)(kn_b + 8 * fq), b01 = *(const f32x4*)(kn_b + 8 * fq + 4), b10 = *(const f32x4*)(kn_b + 32 + 8 * fq), b11 = *(const f32x4*)(kn_b + 36 + 8 * fq);
#pragma unroll
                for (int ai = 0; ai < 2; ++ai)
#pragma unroll
                    for (int m = 0; m < 4; ++m) { const int row = row0 + ai * HALF + m * 16;
                        f32x4 a0 = acc[ai][0][m][0], a1 = acc[ai][0][m][1], c0v = acc[ai][1][m][0], c1v = acc[ai][1][m][1];
                        float s = ((a0[0] + a0[1]) + (a0[2] + a0[3])) + ((a1[0] + a1[1]) + (a1[2] + a1[3])) + ((c0v[0] + c0v[1]) + (c0v[2] + c0v[3])) + ((c1v[0] + c1v[1]) + (c1v[2] + c1v[3]));
                        s += __shfl_xor(s, 16); s += __shfl_xor(s, 32);
                        const float mu = s * (1.f / 64.f);
                        a0 = a0 - mu; a1 = a1 - mu; c0v = c0v - mu; c1v = c1v - mu;
                        float q = ((a0[0] * a0[0] + a0[1] * a0[1]) + (a0[2] * a0[2] + a0[3] * a0[3])) + ((a1[0] * a1[0] + a1[1] * a1[1]) + (a1[2] * a1[2] + a1[3] * a1[3]))
                                + ((c0v[0] * c0v[0] + c0v[1] * c0v[1]) + (c0v[2] * c0v[2] + c0v[3] * c0v[3])) + ((c1v[0] * c1v[0] + c1v[1] * c1v[1]) + (c1v[2] * c1v[2] + c1v[3] * c1v[3]));
                        q += __shfl_xor(q, 16); q += __shfl_xor(q, 32);
                        const float rs = 1.0f / sqrtf(q * (1.f / 64.f) + 1e-5f);
                        a0 = a0 * rs * g00 + b00; a1 = a1 * rs * g01 + b01; c0v = c0v * rs * g10 + b10; c1v = c1v * rs * g11 + b11;
                        rope8(a0, a1, row, fq);
                        float* o = out + (row < MPR ? O_KIP + (size_t)row * 64 : O_KIS + (size_t)(row - MPR) * 64);
                        *(f32x4*)(o + 8 * fq) = a0; *(f32x4*)(o + 8 * fq + 4) = a1; *(f32x4*)(o + 32 + 8 * fq) = c0v; *(f32x4*)(o + 36 + 8 * fq) = c1v;
                        bf16_t* kio = (bf16_t*)(ws + WS_KI) + (size_t)row * 64; st_bf16x8(kio + 8 * fq, a0, a1); st_bf16x8(kio + 32 + 8 * fq, c0v, c1v); }
            } else if (wc == 1) {
                if (fq < 2) {
#pragma unroll
                    for (int ai = 0; ai < 2; ++ai)
#pragma unroll
                        for (int m = 0; m < 4; ++m) { const int row = row0 + ai * HALF + m * 16;
                            float* o = (float*)(ws + WS_WI) + (size_t)row * 16 + 8 * fq; *(f32x4*)o = acc[ai][0][m][0] * 0.03125f; *(f32x4*)(o + 4) = acc[ai][0][m][1] * 0.03125f; }
                }
            }
        }
    }
};
struct EpiF32 {
    static constexpr bool PERM = false, AFTER_DRAIN = false;
    float* O; int ldc;
    __device__ __forceinline__ void operator()(const f32x4 (&acc)[2][2][4][2], const Unit& u, int wr, int wc, int fr, int fq) const {
        const int row0 = u.pm * BM + wr * 64 + fr, col0 = u.pn * BM + wc * 32 + 4 * fq;
#pragma unroll
        for (int ai = 0; ai < 2; ++ai)
#pragma unroll
            for (int m = 0; m < 4; ++m) { float* rowp = O + (size_t)(row0 + ai * HALF + m * 16) * ldc + col0;
#pragma unroll
                for (int bj = 0; bj < 2; ++bj)
#pragma unroll
                    for (int n = 0; n < 2; ++n) *(f32x4*)(rowp + bj * HALF + n * 16) = acc[ai][bj][m][n]; }
    }
};
template <class Epi, class Sched, bool ALIGN_EPI = false, bool SP2 = false>
__device__ __forceinline__ void gemm_phase(PG8_LAS unsigned char* lds, const Gemm g, const Sched& S, const Epi& E) {
    int tid_ = threadIdx.x; asm volatile("" : "+v"(tid_));
    const int tid = tid_, wid = __builtin_amdgcn_readfirstlane(tid >> 6), lane = tid & 63, wr = wid >> 2, wc = wid & 3, fr = lane & 15, fq = lane >> 4;
    const int K = g.K, nt = K / BK;
    unsigned voffA[2], voffB[2];
#pragma unroll
    for (int i = 0; i < 2; ++i) { int R, C; stage_rc(tid * 16 + i * 8192, R, C); const int Rb = Epi::PERM ? ((R & ~31) + perm32(R & 31)) : R;
        voffA[i] = (unsigned)(R * K + C) * 2u; voffB[i] = (unsigned)(Rb * K + C) * 2u; }
    const size_t kstep = (size_t)(BK * 2);
    const size_t hstep = (size_t)HALF * K * 2;
    const size_t tstep = 2 * hstep;
    const unsigned ldsw = (unsigned)wid * 1024u;
    const int aoff = lds_byte(wr * 64 + fr, fq * 8), boff = lds_byte(wc * 32 + fr, fq * 8);
#define PG8_SA(b, h) (((b) * 2 + (h)) * HTB)
#define PG8_SB(b, h) ((4 + (b) * 2 + (h)) * HTB)
#define PG8_STAGE(bufoff, gbase, voff) do { _Pragma("unroll") for (int _i = 0; _i < 2; ++_i) \
        __builtin_amdgcn_global_load_lds((const unsigned*)((const char*)(gbase) + (voff)[_i]), (PG8_LAS unsigned*)(lds + (bufoff) + ldsw + _i * 8192), 16, 0, 0); } while (0)
#define PG8_LDA(dst, b, h) do { _Pragma("unroll") for (int m = 0; m < 4; ++m) _Pragma("unroll") for (int k = 0; k < 2; ++k) dst[m][k] = *(const PG8_LAS bf16x8*)(lds + PG8_SA(b, h) + aoff + m * 2048 + k * 1024); } while (0)
#define PG8_LDB(dst, b, h) do { _Pragma("unroll") for (int n = 0; n < 2; ++n) _Pragma("unroll") for (int k = 0; k < 2; ++k) dst[n][k] = *(const PG8_LAS bf16x8*)(lds + PG8_SB(b, h) + boff + n * 2048 + k * 1024); } while (0)
#define PG8_MMA(ai, bj, At, Bt) do { __builtin_amdgcn_s_setprio(1); _Pragma("unroll") for (int m = 0; m < 4; ++m) _Pragma("unroll") for (int n = 0; n < 2; ++n) _Pragma("unroll") for (int k = 0; k < 2; ++k) \
        acc[ai][bj][m][n] = __builtin_amdgcn_mfma_f32_16x16x32_bf16(Bt[n][k], At[m][k], acc[ai][bj][m][n], 0, 0, 0); __builtin_amdgcn_s_setprio(0); } while (0)
#define PG8_WAIT_V(n) asm volatile("s_waitcnt vmcnt(" #n ")" ::: "memory")
#define PG8_WAIT_L(n) asm volatile("s_waitcnt lgkmcnt(" #n ")" ::: "memory")
#define PG8_BAR __builtin_amdgcn_s_barrier()
#define PG8_SCHED __builtin_amdgcn_sched_barrier(0)
    Unit cur, nxt; int ui = 0;
    if (!S.next(0, cur)) return;
    f32x4 acc[2][2][4][2];
#pragma unroll
    for (int a = 0; a < 2; ++a)
#pragma unroll
        for (int b = 0; b < 2; ++b)
#pragma unroll
            for (int m = 0; m < 4; ++m)
#pragma unroll
                for (int n = 0; n < 2; ++n) acc[a][b][m][n] = (f32x4){0.f, 0.f, 0.f, 0.f};
    bf16x8 At[4][2], B0[2][2], B1[2][2];
    const char* cA = (const char*)g.A + (size_t)cur.pm * tstep; const char* cB = (const char*)g.Bt + (size_t)cur.pn * tstep;
    S.a_ready(cur);
    if constexpr (SP2) {
        PG8_STAGE(PG8_SB(0, 0), cB, voffB); PG8_STAGE(PG8_SB(0, 1), cB + hstep, voffB); PG8_STAGE(PG8_SA(0, 0), cA, voffA); PG8_STAGE(PG8_SA(0, 1), cA + hstep, voffA);
        if (wr == 1) PG8_BAR;
        PG8_WAIT_V(2); PG8_BAR;
        PG8_STAGE(PG8_SB(1, 0), cB + kstep, voffB); PG8_STAGE(PG8_SA(1, 0), cA + kstep, voffA); PG8_STAGE(PG8_SB(1, 1), cB + hstep + kstep, voffB);
        PG8_WAIT_V(6); PG8_BAR;
    } else {
        PG8_STAGE(PG8_SB(0, 0), cB, voffB); PG8_STAGE(PG8_SA(0, 0), cA, voffA); PG8_STAGE(PG8_SB(0, 1), cB + hstep, voffB); PG8_STAGE(PG8_SA(0, 1), cA + hstep, voffA);
        if (wr == 1) PG8_BAR;
        PG8_WAIT_V(4); PG8_BAR;
        PG8_STAGE(PG8_SB(1, 0), cB + kstep, voffB); PG8_STAGE(PG8_SA(1, 0), cA + kstep, voffA); PG8_STAGE(PG8_SB(1, 1), cB + hstep + kstep, voffB);
        PG8_WAIT_V(6); PG8_BAR;
    }
    for (;;) {
        const bool has_next = S.next(ui + 1, nxt);
        const char* nA = has_next ? (const char*)g.A + (size_t)nxt.pm * tstep : cA; const char* nB = has_next ? (const char*)g.Bt + (size_t)nxt.pn * tstep : cB;
        for (int t = 0; t < nt; t += 2) {
            const bool last = (t == nt - 2);
            const char* a1 = cA + (size_t)(t + 1) * kstep;
            const char* a2 = last ? nA : cA + (size_t)(t + 2) * kstep; const char* b2 = last ? nB : cB + (size_t)(t + 2) * kstep;
            const char* a3 = a2 + kstep; const char* b3 = b2 + kstep;
            if (last && has_next) S.a_ready(nxt);
            if constexpr (SP2) {
            PG8_LDB(B0, 0, 0); PG8_LDB(B1, 0, 1); PG8_SCHED; PG8_LDA(At, 0, 0); PG8_STAGE(PG8_SA(1, 1), a1 + hstep, voffA);
            PG8_WAIT_V(8); PG8_WAIT_L(0); PG8_BAR; PG8_MMA(0, 0, At, B0); PG8_MMA(0, 1, At, B1); PG8_BAR; PG8_SCHED;
            PG8_LDA(At, 0, 1); PG8_STAGE(PG8_SB(0, 0), b2, voffB); PG8_STAGE(PG8_SB(0, 1), b2 + hstep, voffB); PG8_STAGE(PG8_SA(0, 0), a2, voffA);
            PG8_WAIT_V(8); PG8_WAIT_L(0); PG8_BAR; PG8_MMA(1, 0, At, B0); PG8_MMA(1, 1, At, B1); PG8_BAR; PG8_SCHED;
            PG8_LDB(B0, 1, 0); PG8_LDB(B1, 1, 1); PG8_SCHED; PG8_LDA(At, 1, 0); PG8_STAGE(PG8_SA(0, 1), a2 + hstep, voffA);
            PG8_WAIT_V(8); PG8_WAIT_L(0); PG8_BAR; PG8_MMA(0, 0, At, B0); PG8_MMA(0, 1, At, B1); PG8_BAR; PG8_SCHED;
            PG8_LDA(At, 1, 1); PG8_STAGE(PG8_SB(1, 0), b3, voffB); PG8_STAGE(PG8_SB(1, 1), b3 + hstep, voffB); PG8_STAGE(PG8_SA(1, 0), a3, voffA);
            PG8_WAIT_V(8); PG8_WAIT_L(0); PG8_BAR; PG8_MMA(1, 0, At, B0); PG8_MMA(1, 1, At, B1); PG8_BAR; PG8_SCHED;
            } else {
            PG8_LDB(B0, 0, 0); PG8_SCHED; PG8_LDA(At, 0, 0); PG8_STAGE(PG8_SA(1, 1), a1 + hstep, voffA);
            PG8_WAIT_L(8); PG8_BAR; PG8_WAIT_L(0); PG8_MMA(0, 0, At, B0); PG8_BAR; PG8_SCHED;
            PG8_LDB(B1, 0, 1); PG8_STAGE(PG8_SB(0, 0), b2, voffB);
            PG8_BAR; PG8_WAIT_L(0); PG8_MMA(0, 1, At, B1); PG8_BAR;
            PG8_LDA(At, 0, 1); PG8_STAGE(PG8_SA(0, 0), a2, voffA);
            PG8_BAR; PG8_WAIT_L(0); PG8_MMA(1, 0, At, B0); PG8_BAR; PG8_SCHED;
            PG8_STAGE(PG8_SB(0, 1), b2 + hstep, voffB);
            PG8_WAIT_V(6); PG8_BAR; PG8_MMA(1, 1, At, B1); PG8_BAR;
            PG8_LDB(B0, 1, 0); PG8_SCHED; PG8_LDA(At, 1, 0); PG8_STAGE(PG8_SA(0, 1), a2 + hstep, voffA);
            PG8_WAIT_L(8); PG8_BAR; PG8_WAIT_L(0); PG8_MMA(0, 0, At, B0); PG8_BAR; PG8_SCHED;
            PG8_LDB(B1, 1, 1); PG8_STAGE(PG8_SB(1, 0), b3, voffB);
            PG8_BAR; PG8_WAIT_L(0); PG8_MMA(0, 1, At, B1); PG8_BAR;
            PG8_LDA(At, 1, 1); PG8_STAGE(PG8_SA(1, 0), a3, voffA);
            PG8_BAR; PG8_WAIT_L(0); PG8_MMA(1, 0, At, B0); PG8_BAR; PG8_SCHED;
            PG8_STAGE(PG8_SB(1, 1), b3 + hstep, voffB);
            PG8_WAIT_V(6); PG8_BAR; PG8_MMA(1, 1, At, B1); PG8_BAR;
            }
        }
        if constexpr (ALIGN_EPI) { if (wr == 0) PG8_BAR; }
        if constexpr (!Epi::AFTER_DRAIN) { E(acc, cur, wr, wc, fr, fq); S.done(cur); }
        if (!has_next) break;
#pragma unroll
        for (int a = 0; a < 2; ++a)
#pragma unroll
            for (int b = 0; b < 2; ++b)
#pragma unroll
                for (int m = 0; m < 4; ++m)
#pragma unroll
                    for (int n = 0; n < 2; ++n) acc[a][b][m][n] = (f32x4){0.f, 0.f, 0.f, 0.f};
        cur = nxt; cA = nA; cB = nB; ++ui;
        if constexpr (ALIGN_EPI) { if (wr == 1) PG8_BAR; }
    }
    PG8_WAIT_V(0);
    if constexpr (!ALIGN_EPI) { if (wr == 0) PG8_BAR; }
    PG8_BAR;
    if constexpr (Epi::AFTER_DRAIN) { E.fused(acc, cur, wr, wc, fr, fq, lds, wid, lane); S.done(cur); }
#undef PG8_SA
#undef PG8_SB
#undef PG8_STAGE
#undef PG8_LDA
#undef PG8_LDB
#undef PG8_MMA
#undef PG8_WAIT_V
#undef PG8_WAIT_L
#undef PG8_BAR
#undef PG8_SCHED
}
}
#include <hip/hip_bf16.h>
#include <cmath>
namespace attn_body {
using bf16=__hip_bfloat16;
using bf16x8=__attribute__((ext_vector_type(8)))short;
using s16x4=__attribute__((ext_vector_type(4)))short;
using f32x16=__attribute__((ext_vector_type(16)))float;
using u32x4=__attribute__((ext_vector_type(4)))unsigned;
constexpr int BATCH=8,NHEAD=8,SEQ=2048,D=64,DM=NHEAD*D;
constexpr int NW=8,QBLK=32,QB=QBLK*NW,KVBLK=64,NQB=SEQ/QB;
constexpr int ATTN_PITCH=DM, ATTN_UNIT_ROWS=QB;
__device__ __forceinline__ int crow(int r,int hi){return (r&3)+8*(r>>2)+4*hi;}
#define SBAR() __builtin_amdgcn_sched_barrier(0)
__device__ __forceinline__ void cmask(f32x16&p0,f32x16&p1,int jb,int qrel,int hi){
  const float NEG=-INFINITY; int kb=64*jb+4*hi;
  #pragma unroll
  for(int r=0;r<16;++r){int kv=kb+(r&3)+8*(r>>2); if(kv>qrel)p0[r]=NEG; if(kv+32>qrel)p1[r]=NEG;}
}

constexpr int NSLOT=3, SLOTB=8192;
constexpr int LDS_K=0, LDS_V=NSLOT*SLOTB, LDS_WS=2*NSLOT*SLOTB, LDS_OST=LDS_WS+NW*64*4, LDS_MSK=LDS_OST+NW*4096, MSK_ROW=264, LDS_BYTES=LDS_MSK+NW*32*MSK_ROW;
constexpr float C2=0.125f*1.4426950408889634f;
__device__ __forceinline__ void glds16(const void*gsrc,unsigned lds_dst){unsigned keep;
  asm volatile("s_mov_b32 %0, m0\n\ts_mov_b32 m0, %2\n\ts_nop 0\n\tglobal_load_lds_dwordx4 %1, off\n\ts_mov_b32 m0, %0":"=&s"(keep):"v"(gsrc),"s"(lds_dst):"memory");}
__device__ __forceinline__ float max3f(float a,float b,float c){float r;asm("v_max3_f32 %0, %1, %2, %3":"=v"(r):"v"(a),"v"(b),"v"(c));return r;}
__device__ __forceinline__ float max2f(float a,float b){float r;asm("v_max_f32_e32 %0, %1, %2":"=v"(r):"v"(a),"v"(b));return r;}
__device__ __forceinline__ float fadd_s(float a,float b){float r;asm("v_add_f32_e32 %0, %1, %2":"=v"(r):"v"(a),"v"(b));return r;}
__device__ __forceinline__ float fsub_s(float a,float b){float r;asm("v_sub_f32_e32 %0, %1, %2":"=v"(r):"v"(a),"v"(b));return r;}
typedef float f32x2_t __attribute__((ext_vector_type(2))); typedef float f32x4_t __attribute__((ext_vector_type(4))); typedef __bf16 bf16x2_t __attribute__((ext_vector_type(2)));
__device__ __forceinline__ unsigned cvtpk_s(float lo,float hi){f32x2_t v={lo,hi};bf16x2_t b=__builtin_convertvector(v,bf16x2_t);return __builtin_bit_cast(unsigned,b);}
#define WAIT_BAR(N) asm volatile("s_waitcnt vmcnt(" #N ") lgkmcnt(0)\n\ts_barrier":::"memory")

__device__ __forceinline__ void qkt(f32x16&p0,f32x16&p1,const char*Kslot,const bf16x8*qr,const f32x16&negm,int r32,int hi){
  const char*kb=Kslot+hi*1024+r32*16;
  #pragma unroll
  for(int d0=0;d0<4;++d0){
    const bf16x8 b0=*reinterpret_cast<const bf16x8*>(kb+d0*2048);
    const bf16x8 b1=*reinterpret_cast<const bf16x8*>(kb+d0*2048+512);
    if(d0==0){p0=__builtin_amdgcn_mfma_f32_32x32x16_bf16(b0,qr[0],negm,0,0,0);p1=__builtin_amdgcn_mfma_f32_32x32x16_bf16(b1,qr[0],negm,0,0,0);}
    else{p0=__builtin_amdgcn_mfma_f32_32x32x16_bf16(b0,qr[d0],p0,0,0,0);p1=__builtin_amdgcn_mfma_f32_32x32x16_bf16(b1,qr[d0],p1,0,0,0);}}
}
typedef __attribute__((address_space(3))) const char* lds_cptr;
typedef short v4i16_t __attribute__((ext_vector_type(4)));
__device__ __forceinline__ void kload8(bf16x8*kf,lds_cptr kp){
  kf[0]=*(const __attribute__((address_space(3))) bf16x8*)(kp);      kf[1]=*(const __attribute__((address_space(3))) bf16x8*)(kp+512);
  kf[2]=*(const __attribute__((address_space(3))) bf16x8*)(kp+2048); kf[3]=*(const __attribute__((address_space(3))) bf16x8*)(kp+2560);
  kf[4]=*(const __attribute__((address_space(3))) bf16x8*)(kp+4096); kf[5]=*(const __attribute__((address_space(3))) bf16x8*)(kp+4608);
  kf[6]=*(const __attribute__((address_space(3))) bf16x8*)(kp+6144); kf[7]=*(const __attribute__((address_space(3))) bf16x8*)(kp+6656);
}
__device__ __forceinline__ void kload2(bf16x8*kf,lds_cptr kp,int j){ kf[2*j]=*(const __attribute__((address_space(3))) bf16x8*)(kp+j*2048); kf[2*j+1]=*(const __attribute__((address_space(3))) bf16x8*)(kp+j*2048+512); }
__device__ __forceinline__ s16x4 vtr(lds_cptr p){ return __builtin_bit_cast(s16x4,__builtin_amdgcn_ds_read_tr16_b64_v4i16((__attribute__((address_space(3))) v4i16_t*)p)); }
__device__ __forceinline__ float rowmax(const f32x16&p0,const f32x16&p1){
  float a=max3f(p0[0],p0[1],p1[0]),b=max3f(p0[2],p0[3],p1[1]);a=max3f(a,p1[2],p1[3]);
  #pragma unroll
  for(int r=4;r<16;r+=4){a=max3f(a,p0[r],p0[r+1]);b=max3f(b,p0[r+2],p0[r+3]);a=max3f(a,p1[r],p1[r+1]);b=max3f(b,p1[r+2],p1[r+3]);}
  const float m=max2f(a,b);
  auto rr=__builtin_amdgcn_permlane32_swap(__float_as_uint(m),__float_as_uint(m),false,false);
  return max2f(__uint_as_float(rr[0]),__uint_as_float(rr[1]));
}
__device__ __forceinline__ void pv(f32x16*o,int vb,bf16x8 pa0,bf16x8 pa1,bf16x8 pa2,bf16x8 pa3){
  #pragma unroll
  for(int d0=0;d0<2;++d0){s16x4 lo[4],hi[4];
    #pragma unroll
    for(int ks=0;ks<4;++ks){
      asm volatile("ds_read_b64_tr_b16 %0,%1 offset:%c2":"=&v"(lo[ks]):"v"(vb),"i"(d0*4096+ks*1024):"memory");
      asm volatile("ds_read_b64_tr_b16 %0,%1 offset:%c2":"=&v"(hi[ks]):"v"(vb),"i"(d0*4096+ks*1024+512):"memory");}
    asm volatile("s_waitcnt lgkmcnt(0)":::"memory");SBAR();
    #define PK(k) (bf16x8){lo[k][0],lo[k][1],lo[k][2],lo[k][3],hi[k][0],hi[k][1],hi[k][2],hi[k][3]}
    o[d0]=__builtin_amdgcn_mfma_f32_32x32x16_bf16(pa0,PK(0),o[d0],0,0,0);
    o[d0]=__builtin_amdgcn_mfma_f32_32x32x16_bf16(pa1,PK(1),o[d0],0,0,0);
    o[d0]=__builtin_amdgcn_mfma_f32_32x32x16_bf16(pa2,PK(2),o[d0],0,0,0);
    o[d0]=__builtin_amdgcn_mfma_f32_32x32x16_bf16(pa3,PK(3),o[d0],0,0,0);
    #undef PK
  }
}

#ifndef ATTN_STORE16
#define ATTN_STORE16(p,v) (*(u32x4*)(p)=(v))
#endif
__device__ __forceinline__ float mask_keep(float v,unsigned W,int bit){ const unsigned u=__float_as_uint(v); const unsigned m=(unsigned)(((int)(W<<(31-bit)))>>31); return __uint_as_float(u&m); }
template<int THRL> __device__ __forceinline__ void attn_unit(int b,int h,int qb,const bf16*Q,const bf16*__restrict__ K,const bf16*__restrict__ V,const unsigned*__restrict__ MSK,const unsigned short*__restrict__ GATE,unsigned short*MIXO,char*shm){
  const int tid=threadIdx.x,lane=tid&63,r32=lane&31,hi=lane>>5; const int wid=__builtin_amdgcn_readfirstlane(tid>>6);
  const long rowbase=(long)b*SEQ; const int q0=qb*QB;
  const bf16*Qw=Q+(rowbase+q0+wid*QBLK)*DM+h*D;
  const bf16*Kh=K+rowbase*DM+h*D,*Vh=V+rowbase*DM+h*D;
  const unsigned lds0=(unsigned)(uintptr_t)shm;
  float*wsf=(float*)(shm+LDS_WS)+wid*64;
  const lds_cptr shm3=(lds_cptr)shm;
  const bf16*ksrc=Kh+(long)lane*DM+wid*8;
  const bf16*vsrc=Vh+(long)(16*(wid&3)+(lane>>2))*DM+(wid>>2)*32+(lane&3)*8;
  const unsigned kdst=lds0+LDS_K+wid*1024, vdst=lds0+LDS_V+wid*1024;
  #define DMA_K(t,slot) glds16(ksrc+(long)(t)*KVBLK*DM,(unsigned)__builtin_amdgcn_readfirstlane(kdst+(slot)))
  #define DMA_V(t,slot) glds16(vsrc+(long)(t)*KVBLK*DM,(unsigned)__builtin_amdgcn_readfirstlane(vdst+(slot)))
  const int vb0=(int)(lds0+LDS_V)+((lane>>4)&1)*32+(lane&3)*8+(4*hi+((lane&15)>>2))*64;
  const char*Kbase=shm+LDS_K; bf16x8 kf[8];
  const lds_cptr kp0=shm3+LDS_K+hi*1024+r32*16; const lds_cptr vp0=shm3+LDS_V+((lane>>4)&1)*32+(lane&3)*8+(4*hi+((lane&15)>>2))*64;
  const int NT=(q0+QB)/KVBLK;
  { const unsigned*mg=MSK+(rowbase+q0+wid*QBLK)*64+lane; __attribute__((address_space(3))) unsigned*ml=(__attribute__((address_space(3))) unsigned*)(shm3+LDS_MSK+wid*32*MSK_ROW)+lane;
    #pragma unroll 8
    for(int i=0;i<32;++i){ const unsigned w=(lane<2*NT)?mg[(long)i*64]:0u; ml[i*(MSK_ROW/4)]=w; }
    asm volatile("s_waitcnt vmcnt(0) lgkmcnt(0)":::"memory"); }
  const lds_cptr mskp=shm3+LDS_MSK+wid*32*MSK_ROW+r32*MSK_ROW;
  #define LDMK(t) const unsigned long long mk_=*(const __attribute__((address_space(3))) unsigned long long*)(mskp+8*(t)); const unsigned mw0_=(unsigned)mk_>>(4*hi), mw1_=(unsigned)(mk_>>32)>>(4*hi)
  #define MK(v,W,bit) mask_keep((v),(W),(bit))
  #define MK16(P,W) do{ _Pragma("unroll") for(int r=0;r<16;++r)P[r]=MK(P[r],W,(r&3)+8*(r>>2)); }while(0)
  DMA_K(0,0);DMA_V(0,0);DMA_K(1,SLOTB);
  bf16x8 qr[4];
  #pragma unroll
  for(int d0=0;d0<4;++d0)qr[d0]=*reinterpret_cast<const bf16x8*>(&Qw[(long)r32*DM+d0*16+hi*8]);
  float mhat=0.f,l_reg=0.f;f32x16 o[2];o[0]=f32x16{};o[1]=f32x16{};f32x16 negm=f32x16{};asm volatile("":"+v"(negm));
  const int qrel=wid*QBLK+r32;
  #define CMASK(P0,P1,t) do{}while(0)
  bool resc=false;
  #define START(P0,P1) do{ const float rm=rowmax(P0,P1); resc=false; \
    { const float dl=rm; mhat=fadd_s(mhat,dl); \
      _Pragma("unroll") for(int r=0;r<16;++r){P0[r]=fsub_s(P0[r],dl);P1[r]=fsub_s(P1[r],dl);} \
      _Pragma("unroll") for(int r=0;r<16;++r)negm[r]=-mhat; asm volatile("":"+v"(negm)); } \
    _Pragma("unroll") for(int r=0;r<16;++r)P0[r]=__builtin_amdgcn_exp2f(P0[r]); }while(0)
  #define RESC() do{ if(resc){ asm volatile("s_waitcnt lgkmcnt(0)":::"memory"); \
      _Pragma("unroll") for(int d_=0;d_<2;++d_) _Pragma("unroll") for(int r=0;r<16;++r)o[d_][r]*=wsf[crow(r,hi)]; } }while(0)
  f32x16 pA0,pA1,pB0,pB1;
  int sl_prev=0,sl_cur=0,sl_next=SLOTB;
  #define ROT() do{sl_prev=sl_cur;sl_cur=sl_next;sl_next=(sl_next==(NSLOT-1)*SLOTB)?0:sl_next+SLOTB;}while(0)
  DMA_K(2,2*SLOTB);
  WAIT_BAR(3);
  qkt(pA0,pA1,Kbase,qr,negm,r32,hi);asm volatile("s_nop 15\n\ts_nop 7":"+v"(pA0),"+v"(pA1));CMASK(pA0,pA1,0);
  START(pA0,pA1);
  _Pragma("unroll") for(int r=0;r<16;++r)pA1[r]=__builtin_amdgcn_exp2f(pA1[r]);
  { LDMK(0); MK16(pA0,mw0_); MK16(pA1,mw1_); }
  WAIT_BAR(0);
  DMA_K(3,0);DMA_V(1,SLOTB);
  ROT();
  kload8(kf,kp0+sl_cur);
  WAIT_BAR(2);
  s16x4 vlo[8],vhi[8]; u32x4 pw0,pw1,pw2,pw3;
  #define PKW(P,B) cvtpk_s(P[B],P[B+1])
  #define PAF(k) __builtin_bit_cast(bf16x8,pw##k)
  #define VFR(i) (bf16x8){vlo[i][0],vlo[i][1],vlo[i][2],vlo[i][3],vhi[i][0],vhi[i][1],vhi[i][2],vhi[i][3]}
  #define PIN(x) asm volatile("":"+v"(x))
  #define MX3(a,b,c) __builtin_fmaxf(__builtin_fmaxf((a),(b)),(c))
  #define GAPA(MF,A0,A1,A2,A3,W0,W1,PW) do{ MF; sacc+=A0; sacc+=A1; sacc+=A2; sacc+=A3; PIN(sacc); W0; W1; PIN(PW); SBAR(); }while(0)
  #define EX(v) __builtin_amdgcn_exp2f(v)
  #define GAPB(MF,X,B,W) do{ MF; X[B]=MK(EX(X[B]),W,8*((B)>>2)); X[B+1]=MK(EX(X[B+1]),W,8*((B)>>2)+1); X[B+2]=MK(EX(X[B+2]),W,8*((B)>>2)+2); X[B+3]=MK(EX(X[B+3]),W,8*((B)>>2)+3); PIN(X); SBAR(); }while(0)
  #define VRD(i) do{ vlo[i]=vtr(vp_+(((i)>>2)*4096+((i)&3)*1024)); vhi[i]=vtr(vp_+(((i)>>2)*4096+((i)&3)*1024+512)); }while(0)
  #define KRD(G,j) do{ if(G){ kload2(kf,kp0+sl_next,j); SBAR(); } }while(0)
  #define STEP(C0,C1,P0,P1,t,GK,GV,GL) do{ SBAR(); LDMK(t); \
    const lds_cptr vp_=vp0+sl_prev; \
    VRD(0); SBAR(); float sacc=(P0[0]+P0[1]); \
    GAPA(C0=__builtin_amdgcn_mfma_f32_32x32x16_bf16(kf[0],qr[0],negm,0,0,0), P0[2],P0[3],P0[4],P0[5],     pw0[0]=PKW(P0,0), pw0[1]=PKW(P0,2), pw0); \
    VRD(4); SBAR(); GAPA(C1=__builtin_amdgcn_mfma_f32_32x32x16_bf16(kf[1],qr[0],negm,0,0,0), P0[6],P0[7],P0[8],P0[9],     pw0[2]=PKW(P0,4), pw0[3]=PKW(P0,6), pw0); \
    VRD(1); SBAR(); GAPA(C0=__builtin_amdgcn_mfma_f32_32x32x16_bf16(kf[2],qr[1],C0,0,0,0),   P0[10],P0[11],P0[12],P0[13], pw1[0]=PKW(P0,8), pw1[1]=PKW(P0,10), pw1); \
    VRD(5); SBAR(); GAPA(C1=__builtin_amdgcn_mfma_f32_32x32x16_bf16(kf[3],qr[1],C1,0,0,0),   P0[14],P0[15],P1[0],P1[1],   pw1[2]=PKW(P0,12),pw1[3]=PKW(P0,14), pw1); \
    VRD(2); SBAR(); GAPA(C0=__builtin_amdgcn_mfma_f32_32x32x16_bf16(kf[4],qr[2],C0,0,0,0),   P1[2],P1[3],P1[4],P1[5],     pw2[0]=PKW(P1,0), pw2[1]=PKW(P1,2), pw2); \
    VRD(6); SBAR(); GAPA(C1=__builtin_amdgcn_mfma_f32_32x32x16_bf16(kf[5],qr[2],C1,0,0,0),   P1[6],P1[7],P1[8],P1[9],     pw2[2]=PKW(P1,4), pw2[3]=PKW(P1,6), pw2); \
    VRD(3); SBAR(); GAPA(C0=__builtin_amdgcn_mfma_f32_32x32x16_bf16(kf[6],qr[3],C0,0,0,0),   P1[10],P1[11],P1[12],P1[13], pw3[0]=PKW(P1,8), pw3[1]=PKW(P1,10), pw3); \
    VRD(7); SBAR(); GAPA(C1=__builtin_amdgcn_mfma_f32_32x32x16_bf16(kf[7],qr[3],C1,0,0,0),   P1[14],P1[15],0.f,0.f,       pw3[2]=PKW(P1,12),pw3[3]=PKW(P1,14), pw3); \
    l_reg+=sacc; \
    if(GK){DMA_K((t)+3,sl_cur);} if(GV){DMA_V((t)+1,sl_next);} \
    CMASK(C0,C1,t); \
    { float a=MX3(C0[0],C0[1],C1[0]),b=MX3(C0[2],C0[3],C1[1]); a=MX3(a,C1[2],C1[3]); \
      _Pragma("unroll") for(int r=4;r<16;r+=4){a=MX3(a,C0[r],C0[r+1]);b=MX3(b,C0[r+2],C0[r+3]);a=MX3(a,C1[r],C1[r+1]);b=MX3(b,C1[r+2],C1[r+3]);} \
      float rm=__builtin_fmaxf(a,b); { auto rr=__builtin_amdgcn_permlane32_swap(__float_as_uint(rm),__float_as_uint(rm),false,false); rm=__builtin_fmaxf(__uint_as_float(rr[0]),__uint_as_float(rr[1])); } \
      resc=false; \
      if(__builtin_expect(__any(rm>(float)THRL),0)){ const float dl=__builtin_fmaxf(rm,0.f); mhat+=dl; \
        _Pragma("unroll") for(int r=0;r<16;++r){C0[r]-=dl;C1[r]-=dl;} \
        _Pragma("unroll") for(int r=0;r<16;++r)negm[r]=-mhat; asm volatile("":"+v"(negm)); \
        const float f=__builtin_amdgcn_exp2f(-dl); l_reg*=f; if(hi==0)wsf[r32]=f; resc=true; } } \
    SBAR(); \
    GAPB(o[0]=__builtin_amdgcn_mfma_f32_32x32x16_bf16(PAF(0),VFR(0),o[0],0,0,0), C0,0,mw0_); \
    GAPB(o[1]=__builtin_amdgcn_mfma_f32_32x32x16_bf16(PAF(0),VFR(4),o[1],0,0,0), C0,4,mw0_); \
    KRD(GL,0); GAPB(o[0]=__builtin_amdgcn_mfma_f32_32x32x16_bf16(PAF(1),VFR(1),o[0],0,0,0), C0,8,mw0_); \
    KRD(GL,1); GAPB(o[1]=__builtin_amdgcn_mfma_f32_32x32x16_bf16(PAF(1),VFR(5),o[1],0,0,0), C0,12,mw0_); \
    KRD(GL,2); GAPB(o[0]=__builtin_amdgcn_mfma_f32_32x32x16_bf16(PAF(2),VFR(2),o[0],0,0,0), C1,0,mw1_); \
    KRD(GL,3); GAPB(o[1]=__builtin_amdgcn_mfma_f32_32x32x16_bf16(PAF(2),VFR(6),o[1],0,0,0), C1,4,mw1_); \
    GAPB(o[0]=__builtin_amdgcn_mfma_f32_32x32x16_bf16(PAF(3),VFR(3),o[0],0,0,0), C1,8,mw1_); \
    GAPB(o[1]=__builtin_amdgcn_mfma_f32_32x32x16_bf16(PAF(3),VFR(7),o[1],0,0,0), C1,12,mw1_); \
    }while(0)
  int t=1;
  #undef CMASK
  #define CMASK(P0,P1,t) do{}while(0)
  for(;t+5<NT;t+=2){
    STEP(pB0,pB1,pA0,pA1,t,true,true,true);     WAIT_BAR(2); RESC(); ROT();
    STEP(pA0,pA1,pB0,pB1,t+1,true,true,true);   WAIT_BAR(2); RESC(); ROT();
  }
  #undef CMASK
  #define CMASK(P0,P1,t) do{}while(0)
  #define ENDW(tt) do{ if((tt)+3<NT){WAIT_BAR(2);} else if((tt)+2<NT){WAIT_BAR(1);} else {WAIT_BAR(0);} }while(0)
  for(;t+1<NT;t+=2){
    STEP(pB0,pB1,pA0,pA1,t,(t+3<NT),(t+1<NT),(t+1<NT));       ENDW(t);   RESC(); ROT();
    STEP(pA0,pA1,pB0,pB1,t+1,(t+4<NT),(t+2<NT),(t+2<NT));     ENDW(t+1); RESC(); ROT();
  }
  STEP(pB0,pB1,pA0,pA1,NT-1,false,false,false); RESC();
  { float sacc=pB0[0]+pB0[1]; _Pragma("unroll") for(int r=2;r<16;++r)sacc+=pB0[r]; _Pragma("unroll") for(int r=0;r<16;++r)sacc+=pB1[r]; l_reg+=sacc;
    pw0=(u32x4){PKW(pB0,0),PKW(pB0,2),PKW(pB0,4),PKW(pB0,6)};pw1=(u32x4){PKW(pB0,8),PKW(pB0,10),PKW(pB0,12),PKW(pB0,14)};pw2=(u32x4){PKW(pB1,0),PKW(pB1,2),PKW(pB1,4),PKW(pB1,6)};pw3=(u32x4){PKW(pB1,8),PKW(pB1,10),PKW(pB1,12),PKW(pB1,14)};
    SBAR(); pv(o,vb0+sl_cur,PAF(0),PAF(1),PAF(2),PAF(3)); }
  #undef PKW
  #undef PAF
  #undef VFR
  #undef PIN
  #undef MX3
  #undef GAPA
  #undef GAPB
  #undef EX
  #undef VRD
  #undef KRD
  #undef STEP
  #undef ENDW
  {auto rr=__builtin_amdgcn_permlane32_swap(__float_as_uint(l_reg),__float_as_uint(l_reg),false,false);l_reg=__uint_as_float(rr[0])+__uint_as_float(rr[1]);}
  if(hi==0)wsf[32+r32]=l_reg;asm volatile("s_waitcnt lgkmcnt(0)":::"memory");
  float rli[16];
  #pragma unroll
  for(int r=0;r<16;++r)rli[r]=__builtin_amdgcn_rcpf(wsf[32+crow(r,hi)]);
  { float*stgf=(float*)(shm+LDS_OST)+wid*1024; const long orow0=rowbase+q0+wid*QBLK;
    #pragma unroll
    for(int d0=0;d0<2;++d0){
      #pragma unroll
      for(int r=0;r<16;++r)stgf[crow(r,hi)*32+r32]=o[d0][r]*rli[r];
      asm volatile("s_waitcnt lgkmcnt(0)":::"memory");
      #pragma unroll
      for(int i=0;i<4;++i){const int row=i*8+(lane>>3),c4=(lane&7)*4; const f32x4_t v=*(const f32x4_t*)(stgf+row*32+c4);
        const unsigned long long gw=*(const unsigned long long*)(GATE+(orow0+row)*512+h*64+d0*32+c4);
        const float g0=__builtin_bit_cast(float,(unsigned)gw<<16),g1=__builtin_bit_cast(float,(unsigned)gw&0xffff0000u),g2=__builtin_bit_cast(float,(unsigned)(gw>>32)<<16),g3=__builtin_bit_cast(float,(unsigned)(gw>>32)&0xffff0000u);
        const unsigned long long ov=(unsigned long long)cvtpk_s(v[0]*g0,v[1]*g1)|((unsigned long long)cvtpk_s(v[2]*g2,v[3]*g3)<<32);
        *(unsigned long long*)(MIXO+(orow0+row)*1024+512+h*64+d0*32+c4)=ov;}
      asm volatile("s_waitcnt lgkmcnt(0)":::"memory"); } }
  asm volatile("s_waitcnt lgkmcnt(0)\n\ts_barrier":::"memory");
  #undef DMA_K
  #undef LDMK
  #undef MK
  #undef MK16
  #undef DMA_V
  #undef CMASK
  #undef START
  #undef RESC
  #undef ROT
}
constexpr int ATTN_LDS_BYTES=LDS_BYTES;
#undef SBAR
#undef WAIT_BAR
}
#define GAS __attribute__((address_space(1)))
#define LAS __attribute__((address_space(3)))
typedef unsigned short bf16;
typedef unsigned v4u __attribute__((ext_vector_type(4)));
typedef float f32x4 __attribute__((ext_vector_type(4)));
typedef short bf16x8 __attribute__((ext_vector_type(8)));
typedef GAS unsigned gu32;
typedef GAS unsigned long long gu64;
#define RLX_AGENT __ATOMIC_RELAXED, __HIP_MEMORY_SCOPE_AGENT
#define LDS_WAIT() asm volatile("s_waitcnt lgkmcnt(0)" ::: "memory")
#define VM_WAIT() asm volatile("s_waitcnt vmcnt(0)" ::: "memory")
__device__ __forceinline__ unsigned long long rt() { return __builtin_amdgcn_s_memrealtime(); }
__device__ __forceinline__ unsigned f2bf(float f) { unsigned u = __builtin_bit_cast(unsigned, f); return (u + 0x7fffu + ((u >> 16) & 1u)) >> 16; }
__device__ __forceinline__ unsigned pk2(float lo, float hi) { return f2bf(lo) | (f2bf(hi) << 16); }

#define XB_TMO      128
#define XB_XCNT(j)  (256  + 64 * (j))
#define XB_XSUB(j)  (1280 + 64 * (j))
#define XB_XGEN(j)  (2304 + 64 * (j))
#define XB_TOP      3328
#define XB_TOPGEN   3392
#define XCD_BAR_WORDS 3456
#define XB_SPIN_CAP (1u << 18)

__device__ __forceinline__ unsigned xb_ld(unsigned* p)              { return __hip_atomic_load(p, __ATOMIC_RELAXED, __HIP_MEMORY_SCOPE_AGENT); }
__device__ __forceinline__ unsigned xb_add(unsigned* p, unsigned v) { return __hip_atomic_fetch_add(p, v, __ATOMIC_RELAXED, __HIP_MEMORY_SCOPE_AGENT); }
__device__ __forceinline__ unsigned xb_xcc_id() { return (unsigned)__builtin_amdgcn_s_getreg((3 << 11) | 20) & 0xFu; }
#define XB_SPIN(cond, bar) do { unsigned _sp = 0; while (cond) { __builtin_amdgcn_s_sleep(1); \
    if ((++_sp & 255u) == 0u) { if (xb_ld(&(bar)[XB_TMO])) break; if (_sp > XB_SPIN_CAP) { atomicAdd(&(bar)[XB_TMO], 1u); break; } } } } while (0)

struct XcdBarrier {
    unsigned* bar; unsigned x;
    volatile LAS unsigned* st;
};

__device__ __forceinline__ XcdBarrier xcd_barrier_post(unsigned* bar, volatile LAS unsigned* st) {
    XcdBarrier b; b.bar = bar; b.x = xb_xcc_id(); b.st = st;
    if (threadIdx.x == 0) (void)xb_add(&bar[XB_XCNT(b.x)], 1u);
    return b;
}
__device__ __forceinline__ void xcd_barrier_complete(unsigned* bar, unsigned x, unsigned& nloc, unsigned& nx) {
    const unsigned G = gridDim.x * gridDim.y * gridDim.z;
    unsigned sum, cnt, mine, sp = 0u;
    for (;;) {
        sum = 0u; cnt = 0u; mine = 0u;
#pragma unroll
        for (unsigned j = 0; j < 16; ++j) { const unsigned c = xb_ld(&bar[XB_XCNT(j)]); sum += c; cnt += (c > 0u) ? 1u : 0u; mine = (j == x) ? c : mine; }
        if (sum == G) break;
        __builtin_amdgcn_s_sleep(1);
        if ((++sp & 255u) == 0u) { if (xb_ld(&bar[XB_TMO])) break; if (sp > XB_SPIN_CAP) { atomicAdd(&bar[XB_TMO], 1u); break; } }
    }
    nloc = mine > 0u ? mine : 1u; nx = cnt > 0u ? cnt : 1u;
}

__device__ __forceinline__ void xcd_barrier(const XcdBarrier& b) {
    asm volatile("s_waitcnt vmcnt(0)" ::: "memory");
    __syncthreads();
    if (threadIdx.x == 0) {
        unsigned* bar = b.bar;
        __builtin_amdgcn_s_waitcnt(0);
        unsigned nloc = b.st[0], nx = b.st[1];
        if (nloc == 0u) { xcd_barrier_complete(bar, b.x, nloc, nx); b.st[0] = nloc; b.st[1] = nx; }
        const unsigned old = xb_add(&bar[XB_XSUB(b.x)], 1u);
        const unsigned gen = old / nloc;
        if (old + 1u == (gen + 1u) * nloc) {
            __builtin_amdgcn_fence(__ATOMIC_RELEASE, "agent");
            asm volatile("s_waitcnt vmcnt(0)" ::: "memory");
            const unsigned og = xb_add(&bar[XB_TOP], 1u);
            const unsigned tg = og / nx;
            if (og + 1u == (tg + 1u) * nx) xb_add(&bar[XB_TOPGEN], 1u);
            else XB_SPIN(xb_ld(&bar[XB_TOPGEN]) == tg, bar);
            __builtin_amdgcn_fence(__ATOMIC_ACQUIRE, "agent");
            xb_add(&bar[XB_XGEN(b.x)], 1u);
            asm volatile("s_waitcnt vmcnt(0)" ::: "memory");
        } else {
            XB_SPIN(xb_ld(&bar[XB_XGEN(b.x)]) == gen, bar);
            __builtin_amdgcn_fence(__ATOMIC_ACQUIRE, "agent");
            asm volatile("s_waitcnt vmcnt(0)" ::: "memory");
        }
    }
    __syncthreads();
}
typedef float f32x16 __attribute__((ext_vector_type(16)));
typedef unsigned short us8 __attribute__((ext_vector_type(8)));
__device__ __forceinline__ float bf2f(unsigned short h) { return __builtin_bit_cast(float, (unsigned)h << 16); }
__device__ __forceinline__ float ex2(float x) { return __builtin_amdgcn_exp2f(x); }
constexpr float LOG2E = 1.4426950408889634f;
__device__ __forceinline__ float wave_sum(float v) {
#pragma unroll
    for (int o = 1; o < 64; o <<= 1) v += __shfl_xor(v, o);
    return v;
}
constexpr int HG_QT = 0, HG_KT = 17408, HG_KTT = 34816, HG_VT = 53248, HG_SB = 71680, HG_P = 106496, HG_OB = 115712, HG_AL = 149504, HG_SEG = 150016, HG_END = 152064;
constexpr int ST_K = 272, ST_T = 144, ST_O = 528;
static_assert(HG_END <= MISC_OFF, "HGRN LDS map");
__device__ __forceinline__ bf16x8 ldfrag(const LAS unsigned char* base, int row, int stride, int kelem) { return *(const LAS bf16x8*)(base + row * stride + kelem * 2); }

template <bool FULL>
__device__ __forceinline__ void hgrn_prompt_unit(LAS unsigned char* L, unsigned char* ws, float* out, const float* norm_g, int unit, int tid) {
    const int lane = tid & 63, wave = __builtin_amdgcn_readfirstlane(tid >> 6), r32 = lane & 31, hh = lane >> 5;
    const int b = unit >> 5, h = (unit >> 3) & 3, sc = unit & 7;
    const float* LOGF = (const float*)(ws + WS_LOGF); const bf16* QA = (const bf16*)(ws + WS_QA); const bf16* VA = (const bf16*)(ws + WS_VA); const bf16* GA = (const bf16*)(ws + WS_GA);
    float* U = (float*)(ws + WS_U); float* ASC = (float*)(ws + WS_ASC); bf16* MIX = (bf16*)(ws + WS_MIX);
    const int kch = tid & 127, seg = tid >> 7;
    const int vi = wave & 3, kp = wave >> 2;
    f32x16 S0 = {}, S1 = {};
    if (FULL) {
        for (int j = 0; j < sc; ++j) { const int uj = unit - sc + j; const float* Uj = U + (size_t)uj * 16384; const float* Aj = ASC + uj * 128;
#pragma unroll
            for (int r = 0; r < 16; ++r) { const int k0 = 64 * kp + (r & 3) + 8 * (r >> 2) + 4 * hh;
                S0[r] = Aj[k0] * S0[r] + Uj[k0 * 128 + 32 * vi + r32]; S1[r] = Aj[k0 + 32] * S1[r] + Uj[(k0 + 32) * 128 + 32 * vi + r32]; } }
#pragma unroll
        for (int g = 0; g < 4; ++g) { unsigned long long w0 = (unsigned long long)pk2(S0[4 * g], S0[4 * g + 1]) | ((unsigned long long)pk2(S0[4 * g + 2], S0[4 * g + 3]) << 32);
            unsigned long long w1 = (unsigned long long)pk2(S1[4 * g], S1[4 * g + 1]) | ((unsigned long long)pk2(S1[4 * g + 2], S1[4 * g + 3]) << 32);
            *(LAS unsigned long long*)(L + HG_SB + (32 * vi + r32) * ST_K + (64 * kp + 8 * g + 4 * hh) * 2) = w0;
            *(LAS unsigned long long*)(L + HG_SB + (32 * vi + r32) * ST_K + (64 * kp + 32 + 8 * g + 4 * hh) * 2) = w1; }
    }
    float atot = 0.f;
    for (int c = 0; c < 4; ++c) {
        const int row0 = b * SEQ + sc * 256 + c * 64;
        float cum[16]; { float run = 0.f;
#pragma unroll
            for (int i = 0; i < 16; ++i) { run += LOGF[(size_t)(row0 + seg * 16 + i) * 512 + h * 128 + kch]; cum[i] = run; }
            ((LAS float*)(L + HG_SEG))[seg * 128 + kch] = run; }
        unsigned short vv[16];
#pragma unroll
        for (int i = 0; i < 16; ++i) vv[i] = VA[(size_t)(row0 + seg * 16 + i) * 512 + h * 128 + kch];
        unsigned short qq[16];
        if (FULL) {
#pragma unroll
            for (int i = 0; i < 16; ++i) qq[i] = QA[(size_t)(row0 + seg * 16 + i) * 512 + h * 128 + kch]; }
        __syncthreads();
        { const LAS float* sg = (const LAS float*)(L + HG_SEG); const float t0 = sg[kch], t1 = sg[128 + kch], t2 = sg[256 + kch], t3 = sg[384 + kch];
          const float off = seg == 0 ? 0.f : (seg == 1 ? t0 : (seg == 2 ? t0 + t1 : t0 + t1 + t2)); const float tot = (t0 + t1) + (t2 + t3);
          if (seg == 0) { ((LAS float*)(L + HG_AL))[kch] = ex2(tot * LOG2E); atot += tot; }
          unsigned short kt[16], qt[16]; float prev = 0.f;
#pragma unroll
          for (int i = 0; i < 16; ++i) { const float g = cum[i] - prev; prev = cum[i]; const float cm = cum[i] + off;
              const float f = ex2(g * LOG2E); const float kk = (1.f - f) * ex2(-cm * LOG2E); kt[i] = (unsigned short)f2bf(kk);
              if (FULL) { const float qv = bf2f(qq[i]) * ex2(cm * LOG2E); qt[i] = (unsigned short)f2bf(qv);
                  *(LAS unsigned short*)(L + HG_QT + (seg * 16 + i) * ST_K + kch * 2) = qt[i]; *(LAS unsigned short*)(L + HG_KT + (seg * 16 + i) * ST_K + kch * 2) = kt[i]; } }
          us8 w0, w1, x0, x1;
#pragma unroll
          for (int i = 0; i < 8; ++i) { w0[i] = kt[i]; w1[i] = kt[8 + i]; x0[i] = vv[i]; x1[i] = vv[8 + i]; }
          *(LAS us8*)(L + HG_KTT + kch * ST_T + seg * 32) = w0; *(LAS us8*)(L + HG_KTT + kch * ST_T + seg * 32 + 16) = w1;
          *(LAS us8*)(L + HG_VT + kch * ST_T + seg * 32) = x0; *(LAS us8*)(L + HG_VT + kch * ST_T + seg * 32 + 16) = x1; }
        __syncthreads();
        f32x16 o = {};
        if (FULL) {
            const int ti = wave >> 2;
            if (wave < 3) { const int si = wave == 2 ? 1 : 0, tj = wave == 0 ? 0 : 1; f32x16 p = {};
#pragma unroll
                for (int ks = 0; ks < 8; ++ks) p = __builtin_amdgcn_mfma_f32_32x32x16_bf16(ldfrag(L + HG_KT, 32 * si + r32, ST_K, 16 * ks + 8 * hh), ldfrag(L + HG_QT, 32 * tj + r32, ST_K, 16 * ks + 8 * hh), p, 0, 0, 0);
                const int t = 32 * tj + r32;
#pragma unroll
                for (int g = 0; g < 4; ++g) { float e[4];
#pragma unroll
                    for (int j = 0; j < 4; ++j) { const int s = 32 * si + 8 * g + 4 * hh + j; e[j] = s <= t ? p[4 * g + j] : 0.f; }
                    *(LAS unsigned long long*)(L + HG_P + t * ST_T + (32 * si + 8 * g + 4 * hh) * 2) = (unsigned long long)pk2(e[0], e[1]) | ((unsigned long long)pk2(e[2], e[3]) << 32); } }
#pragma unroll
            for (int ks = 0; ks < 8; ++ks) o = __builtin_amdgcn_mfma_f32_32x32x16_bf16(ldfrag(L + HG_QT, 32 * ti + r32, ST_K, 16 * ks + 8 * hh), ldfrag(L + HG_SB, 32 * vi + r32, ST_K, 16 * ks + 8 * hh), o, 0, 0, 0);
            __syncthreads();
#pragma unroll
            for (int ks = 0; ks < 4; ++ks) if (ks < 2 * (ti + 1)) o = __builtin_amdgcn_mfma_f32_32x32x16_bf16(ldfrag(L + HG_P, 32 * ti + r32, ST_T, 16 * ks + 8 * hh), ldfrag(L + HG_VT, 32 * vi + r32, ST_T, 16 * ks + 8 * hh), o, 0, 0, 0);
        }
#pragma unroll
        for (int ks = 0; ks < 4; ++ks) { const bf16x8 bv = ldfrag(L + HG_VT, 32 * vi + r32, ST_T, 16 * ks + 8 * hh);
            S0 = __builtin_amdgcn_mfma_f32_32x32x16_bf16(ldfrag(L + HG_KTT, 64 * kp + r32, ST_T, 16 * ks + 8 * hh), bv, S0, 0, 0, 0);
            S1 = __builtin_amdgcn_mfma_f32_32x32x16_bf16(ldfrag(L + HG_KTT, 64 * kp + 32 + r32, ST_T, 16 * ks + 8 * hh), bv, S1, 0, 0, 0); }
        { const LAS float* al = (const LAS float*)(L + HG_AL);
#pragma unroll
          for (int r = 0; r < 16; ++r) { const int k0 = 64 * kp + (r & 3) + 8 * (r >> 2) + 4 * hh; S0[r] *= al[k0]; S1[r] *= al[k0 + 32]; } }
        if (FULL) {
#pragma unroll
            for (int g = 0; g < 4; ++g) { unsigned long long w0 = (unsigned long long)pk2(S0[4 * g], S0[4 * g + 1]) | ((unsigned long long)pk2(S0[4 * g + 2], S0[4 * g + 3]) << 32);
                unsigned long long w1 = (unsigned long long)pk2(S1[4 * g], S1[4 * g + 1]) | ((unsigned long long)pk2(S1[4 * g + 2], S1[4 * g + 3]) << 32);
                *(LAS unsigned long long*)(L + HG_SB + (32 * vi + r32) * ST_K + (64 * kp + 8 * g + 4 * hh) * 2) = w0;
                *(LAS unsigned long long*)(L + HG_SB + (32 * vi + r32) * ST_K + (64 * kp + 32 + 8 * g + 4 * hh) * 2) = w1; }
            const int ti = wave >> 2;
#pragma unroll
            for (int r = 0; r < 16; ++r) *(LAS float*)(L + HG_OB + (32 * ti + (r & 3) + 8 * (r >> 2) + 4 * hh) * ST_O + (32 * vi + r32) * 4) = o[r];
            __syncthreads();
            { const int t = tid >> 3, j = tid & 7; const LAS float* ob = (const LAS float*)(L + HG_OB + t * ST_O) + 16 * j; float v[16]; float ss = 0.f;
#pragma unroll
              for (int i = 0; i < 4; ++i) { const f32x4 x = *(const LAS f32x4*)(ob + 4 * i); v[4 * i] = x[0]; v[4 * i + 1] = x[1]; v[4 * i + 2] = x[2]; v[4 * i + 3] = x[3]; ss += (x[0] * x[0] + x[1] * x[1]) + (x[2] * x[2] + x[3] * x[3]); }
              ss += __shfl_xor(ss, 1); ss += __shfl_xor(ss, 2); ss += __shfl_xor(ss, 4);
              const float rs = 1.0f / sqrtf(ss * (1.f / 128.f) + LN_EPS);
              const size_t gi = (size_t)(row0 + t) * 512 + h * 128 + 16 * j; const v4u g0 = *(const GAS v4u*)(GA + gi), g1 = *(const GAS v4u*)(GA + gi + 8);
              const unsigned gw[8] = {g0.x, g0.y, g0.z, g0.w, g1.x, g1.y, g1.z, g1.w}; unsigned ow[8];
#pragma unroll
              for (int i = 0; i < 8; ++i) { const float ga = __builtin_bit_cast(float, gw[i] << 16), gb = __builtin_bit_cast(float, gw[i] & 0xffff0000u);
                  ow[i] = pk2(v[2 * i] * rs * norm_g[16 * j + 2 * i] * ga, v[2 * i + 1] * rs * norm_g[16 * j + 2 * i + 1] * gb); }
              bf16* mo = MIX + (size_t)(row0 + t) * 1024 + h * 128 + 16 * j;
              *(GAS v4u*)mo = (v4u){ow[0], ow[1], ow[2], ow[3]}; *(GAS v4u*)(mo + 8) = (v4u){ow[4], ow[5], ow[6], ow[7]}; }
        }
    }
    if (!FULL) {
        float* Uu = U + (size_t)unit * 16384;
#pragma unroll
        for (int r = 0; r < 16; ++r) { const int k0 = 64 * kp + (r & 3) + 8 * (r >> 2) + 4 * hh; Uu[k0 * 128 + 32 * vi + r32] = S0[r]; Uu[(k0 + 32) * 128 + 32 * vi + r32] = S1[r]; }
        if (seg == 0) ASC[unit * 128 + kch] = ex2(atot * LOG2E);
    } else if (sc == 7) {
        float* So = out + O_SP + (size_t)(b * 4 + h) * 16384;
#pragma unroll
        for (int r = 0; r < 16; ++r) { const int k0 = 64 * kp + (r & 3) + 8 * (r >> 2) + 4 * hh; So[k0 * 128 + 32 * vi + r32] = S0[r]; So[(k0 + 32) * 128 + 32 * vi + r32] = S1[r]; }
    }
    __syncthreads();
}

__device__ __forceinline__ void hgrn_sample_unit(LAS unsigned char* L, unsigned char* ws, float* out, const float* state_in, const float* norm_g, int unit, int tid) {
    const int b = unit >> 2, h = unit & 3, v = tid & 127, kq = tid >> 7;
    const float* LOGF = (const float*)(ws + WS_LOGF); const bf16* QA = (const bf16*)(ws + WS_QA); const bf16* VA = (const bf16*)(ws + WS_VA); const bf16* GA = (const bf16*)(ws + WS_GA); bf16* MIX = (bf16*)(ws + WS_MIX);
    LAS float* qt = (LAS float*)L; LAS float* kt = qt + 1024; LAS float* vv = kt + 1024; LAS float* al = vv + 1024; LAS float* part = al + 128;
    const int row0 = MP + b * 8;
    float S[32]; const float* Sin = state_in + (size_t)unit * 16384;
#pragma unroll
    for (int i = 0; i < 32; ++i) S[i] = Sin[(kq * 32 + i) * 128 + v];
    if (tid < 128) { float cm = 0.f;
#pragma unroll
        for (int t = 0; t < 8; ++t) { const size_t gi = (size_t)(row0 + t) * 512 + h * 128 + tid; const float g = LOGF[gi]; cm += g;
            qt[t * 128 + tid] = bf2f(QA[gi]) * ex2(cm * LOG2E); kt[t * 128 + tid] = (1.f - ex2(g * LOG2E)) * ex2(-cm * LOG2E); }
        al[tid] = ex2(cm * LOG2E); }
    else if (tid < 256) { const int vc = tid - 128;
#pragma unroll
        for (int t = 0; t < 8; ++t) vv[t * 128 + vc] = bf2f(VA[(size_t)(row0 + t) * 512 + h * 128 + vc]); }
    __syncthreads();
#pragma unroll
    for (int t = 0; t < 8; ++t) { const float vt = vv[t * 128 + v]; float acc = 0.f;
#pragma unroll
        for (int i = 0; i < 32; ++i) { S[i] += kt[t * 128 + kq * 32 + i] * vt; acc += qt[t * 128 + kq * 32 + i] * S[i]; }
        part[(t * 4 + kq) * 128 + v] = acc; }
    float* So = out + O_SS + (size_t)unit * 16384;
#pragma unroll
    for (int i = 0; i < 32; ++i) So[(kq * 32 + i) * 128 + v] = S[i] * al[kq * 32 + i];
    __syncthreads();
    { const int t = tid >> 6, l = tid & 63; const float o0 = (part[(t * 4) * 128 + l] + part[(t * 4 + 1) * 128 + l]) + (part[(t * 4 + 2) * 128 + l] + part[(t * 4 + 3) * 128 + l]);
      const float o1 = (part[(t * 4) * 128 + 64 + l] + part[(t * 4 + 1) * 128 + 64 + l]) + (part[(t * 4 + 2) * 128 + 64 + l] + part[(t * 4 + 3) * 128 + 64 + l]);
      const float ss = wave_sum(o0 * o0 + o1 * o1); const float rs = 1.0f / sqrtf(ss * (1.f / 128.f) + LN_EPS);
      const size_t gi = (size_t)(row0 + t) * 512 + h * 128; bf16* mo = MIX + (size_t)(row0 + t) * 1024 + h * 128;
      mo[l] = (bf16)f2bf(o0 * rs * norm_g[l] * bf2f(GA[gi + l])); mo[64 + l] = (bf16)f2bf(o1 * rs * norm_g[64 + l] * bf2f(GA[gi + 64 + l])); }
    __syncthreads();
}
constexpr int IX_KST = 144;
constexpr int IX_BUF = 256 * IX_KST;
#define DPP_I(v, ctrl, rmask) __builtin_amdgcn_update_dpp(0, (v), (ctrl), (rmask), 0xF, false)
__device__ __forceinline__ void half_sums_i(int v, int& s0, int& s1) {
    v += DPP_I(v, 0xB1, 0xF); v += DPP_I(v, 0x4E, 0xF); v += DPP_I(v, 0x141, 0xF); v += DPP_I(v, 0x140, 0xF); v += DPP_I(v, 0x142, 0xA);
    s0 = __builtin_amdgcn_readlane(v, 31); s1 = __builtin_amdgcn_readlane(v, 63); }
#define DPP_ADDF(v, ctrl, rmask) ((v) + __builtin_bit_cast(float, __builtin_amdgcn_update_dpp(0, __builtin_bit_cast(int, (v)), (ctrl), (rmask), 0xF, false)))
__device__ __forceinline__ void half_sums_f(float v, float& s0, float& s1) {
    v = DPP_ADDF(v, 0xB1, 0xF); v = DPP_ADDF(v, 0x4E, 0xF); v = DPP_ADDF(v, 0x141, 0xF); v = DPP_ADDF(v, 0x140, 0xF); v = DPP_ADDF(v, 0x142, 0xA);
    s0 = __builtin_bit_cast(float, __builtin_amdgcn_readlane(__builtin_bit_cast(int, v), 31)); s1 = __builtin_bit_cast(float, __builtin_amdgcn_readlane(__builtin_bit_cast(int, v), 63)); }
#ifndef IDX_SR
#define IDX_SR 1
#endif

__device__ __forceinline__ void indexer_prompt_unit(LAS unsigned char* L, unsigned char* ws, int b, int u, int tid) {
    const int lane = tid & 63, wave = __builtin_amdgcn_readfirstlane(tid >> 6), r32 = lane & 31, hh = lane >> 5;
    const bf16* QI = (const bf16*)(ws + WS_QI); const bf16* KI = (const bf16*)(ws + WS_KI); const float* WI = (const float*)(ws + WS_WI); unsigned* MASK = (unsigned*)(ws + WS_MASK);
    const int t0 = 16 * u, NKT = (u >> 1) + 1;
    const int tq = t0 + 2 * wave + hh;
    bf16x8 afr[4]; { const int tok = t0 + 2 * wave + ((r32 >> 2) & 1), head = (r32 & 3) + 4 * (r32 >> 3); const bf16* qp = QI + (size_t)(b * SEQ + tok) * 1024 + head * 64 + 8 * hh;
#pragma unroll
        for (int ks = 0; ks < 4; ++ks) afr[ks] = *(const bf16x8*)(qp + 16 * ks); }
    float wv[16]; { const f32x4* wp = (const f32x4*)(WI + (size_t)(b * SEQ + tq) * 16);
#pragma unroll
        for (int i = 0; i < 4; ++i) { const f32x4 x = wp[i]; wv[4 * i] = x[0]; wv[4 * i + 1] = x[1]; wv[4 * i + 2] = x[2]; wv[4 * i + 3] = x[3]; } }
    float sc[64];
#pragma unroll
    for (int j = 0; j < 64; ++j) sc[j] = -__builtin_inff();
    const char* kbase = (const char*)(KI + (size_t)b * SEQ * 64);
    v4u stg[4];
#pragma unroll
    for (int i = 0; i < 4; ++i) { const int q = tid + 512 * i; stg[i] = *(const v4u*)(kbase + (size_t)(q >> 3) * 128 + (q & 7) * 16); }
#pragma unroll
    for (int i = 0; i < 4; ++i) { const int q = tid + 512 * i; *(LAS v4u*)(L + (q >> 3) * IX_KST + (q & 7) * 16) = stg[i]; }
    __syncthreads();
    f32x16 accA = {}, accB = {};
#pragma unroll
    for (int c = 0; c < 9; ++c) {
        const bool active = (c < 8) && (8 * c < NKT);
        const bool more = (c < 7) && (8 * (c + 1) < NKT);
        if (active && more) {
#pragma unroll
            for (int i = 0; i < 4; ++i) { const int q = tid + 512 * i; stg[i] = *(const v4u*)(kbase + (size_t)(256 * (c + 1) + (q >> 3)) * 128 + (q & 7) * 16); } }
        const LAS unsigned char* kb = L + (c & 1) * IX_BUF;
#pragma unroll
        for (int jj = 0; jj < 8; ++jj) {
            const int j = 8 * c + jj;
            if (j <= 64) {
                if (j < 64 && j < NKT) {
                    f32x16 a = {};
#pragma unroll
                    for (int ks = 0; ks < 4; ++ks) a = __builtin_amdgcn_mfma_f32_32x32x16_bf16(afr[ks], *(const LAS bf16x8*)(kb + (32 * jj + r32) * IX_KST + (16 * ks + 8 * hh) * 2), a, 0, 0, 0);
                    if (j & 1) accB = a; else accA = a;
                }
                if (j >= 1 && j - 1 < NKT) {
                    const f32x16 p = ((j - 1) & 1) ? accB : accA; float I0 = 0.f, I1 = 0.f;
#pragma unroll
                    for (int r = 0; r < 16; r += 2) { const float f0 = p[r], f1 = p[r + 1]; const int x0 = __float_as_int(f0), x1 = __float_as_int(f1);
                        I0 += wv[r] * __int_as_float(x0 > 0 ? x0 : 0); I1 += wv[r + 1] * __int_as_float(x1 > 0 ? x1 : 0); }
                    float I = I0 + I1;
                    if (j == NKT) I = ((32 * (j - 1) + r32) <= tq) ? I : -__builtin_inff();
                    sc[j - 1] = I;
                    asm volatile("" : "+v"(sc[j - 1]) :: "memory");
                }
            }
        }
        if (active) {
            if (more) {
#pragma unroll
                for (int i = 0; i < 4; ++i) { const int q = tid + 512 * i; *(LAS v4u*)(L + ((c + 1) & 1) * IX_BUF + (q >> 3) * IX_KST + (q & 7) * 16) = stg[i]; } }
            __syncthreads();
        }
    }
    float tau = -3.0e38f;
    if (u >= 16) for (int sr_ = 0; sr_ < IDX_SR; ++sr_) {
        float s1 = 0.f, s2 = 0.f, sn = 0.f;
#pragma unroll
        for (int j = 0; j < 64; j += 4) if (j < NKT) { const bool ok = sc[j] > -3.0e38f; const float v = ok ? sc[j] : 0.f; s1 += v; s2 += v * v; sn += ok ? 1.f : 0.f; }
        float a0, a1, b0, b1, c0, c1; half_sums_f(s1, a0, a1); half_sums_f(s2, b0, b1); half_sums_f(sn, c0, c1);
        const float ns = hh ? c1 : c0, m1 = (hh ? a1 : a0) / ns, m2 = (hh ? b1 : b0) / ns;
        const float mu = m1, sd = sqrtf(fmaxf(m2 - m1 * m1, 1e-30f));
        const float n = (float)(tq + 1);
        const float p = 256.f / n; const float z = __builtin_amdgcn_logf((1.f - p) / p) * (0.6931471805599453f / 1.702f);
        float lo = 0.f, hi = 0.f, clo = 0.f, chi = 0.f; bool hlo = false, hhi = false, done = false;
        float cand = mu + z * sd; float step = 0.25f * sd;
        for (int it = 0; it < 64; ++it) {
            int cnt = 0;
#pragma unroll
            for (int g = 0; g < 8; ++g) if (8 * g < NKT) {
#pragma unroll
                for (int jj = 0; jj < 8; ++jj) cnt += (sc[8 * g + jj] >= cand) ? 1 : 0; }
            int k0, k1; half_sums_i(cnt, k0, k1);
            const float C = (float)(hh ? k1 : k0);
            if (!done) {
                if (C == 256.f) { tau = cand; done = true; }
                else {
                    if (C > 256.f) { lo = cand; clo = C; hlo = true; } else { hi = cand; chi = C; hhi = true; }
                    float nx;
                    if (hlo && hhi) {
                        float fr = (clo - 256.f) * __builtin_amdgcn_rcpf(clo - chi); fr = fminf(fmaxf(fr, 0.02f), 0.98f); if ((it & 3) == 3) fr = 0.5f;
                        nx = lo + (hi - lo) * fr;
                        if (!(nx > lo) || !(nx < hi)) { nx = 0.5f * lo + 0.5f * hi; if (!(nx > lo) || !(nx < hi)) { tau = lo; done = true; } }
                    } else { nx = (C > 256.f) ? cand + step : cand - step; step *= 2.f; }
                    cand = nx;
                }
            }
            if (!__any(!done)) break;
        }
        if (!done) tau = hlo ? lo : -3.0e38f;
    }
    unsigned mw0 = 0u, mw1 = 0u;
#pragma unroll
    for (int j = 0; j < 64; ++j) if (j < NKT) { const unsigned long long m = __ballot(sc[j] >= tau); const unsigned m_lo = (unsigned)m, m_hi = (unsigned)(m >> 32);
        mw0 = (lane == j) ? m_lo : mw0; mw1 = (lane == j) ? m_hi : mw1; }
    unsigned* mr = MASK + (size_t)(b * SEQ + t0 + 2 * wave) * 64 + lane; mr[0] = mw0; mr[64] = mw1;
    __syncthreads();
}
__device__ __forceinline__ void sample_scores_unit(LAS unsigned char* L, unsigned char* ws, const float* cache_kidx, const int* page_table, int b, int pg, int tid) {
    const int lane = tid & 63, wave = __builtin_amdgcn_readfirstlane(tid >> 6), r32 = lane & 31, hh = lane >> 5, a = wave & 3, kh = wave >> 2;
    const bf16* QI = (const bf16*)(ws + WS_QI); const float* WI = (const float*)(ws + WS_WI); float* SC = (float*)(ws + WS_SCORES);
    bf16x8 afr[4]; { const int tok = 2 * a + ((r32 >> 2) & 1), head = (r32 & 3) + 4 * (r32 >> 3); const bf16* qp = QI + (size_t)(MP + b * 8 + tok) * 1024 + head * 64 + 8 * hh;
#pragma unroll
        for (int ks = 0; ks < 4; ++ks) afr[ks] = *(const bf16x8*)(qp + 16 * ks); }
    float wv[16]; { const f32x4* wp = (const f32x4*)(WI + (size_t)(MP + b * 8 + 2 * a + hh) * 16);
#pragma unroll
        for (int i = 0; i < 4; ++i) { const f32x4 x = wp[i]; wv[4 * i] = x[0]; wv[4 * i + 1] = x[1]; wv[4 * i + 2] = x[2]; wv[4 * i + 3] = x[3]; } }
    f32x4 stg[8];
#define SS_LOAD(st) do { _Pragma("unroll") for (int i = 0; i < 4; ++i) { const int q = tid + 512 * i, key = q >> 3; const int phys = page_table[b * NPAGES + 8 * pg + 2 * (st) + (key >> 7)]; \
        const float* src = cache_kidx + ((size_t)phys * PAGE + (key & 127)) * 64 + 8 * (q & 7); stg[2 * i] = *(const f32x4*)src; stg[2 * i + 1] = *(const f32x4*)(src + 4); } } while (0)
#define SS_STORE(buf) do { _Pragma("unroll") for (int i = 0; i < 4; ++i) { const int q = tid + 512 * i; v4u o; o.x = pk2(stg[2 * i][0], stg[2 * i][1]); o.y = pk2(stg[2 * i][2], stg[2 * i][3]); o.z = pk2(stg[2 * i + 1][0], stg[2 * i + 1][1]); o.w = pk2(stg[2 * i + 1][2], stg[2 * i + 1][3]); \
        *(LAS v4u*)(L + (buf) * IX_BUF + (q >> 3) * IX_KST + (q & 7) * 16) = o; } } while (0)
    SS_LOAD(0); SS_STORE(0);
    __syncthreads();
#pragma unroll
    for (int st = 0; st < 4; ++st) {
        if (st < 3) SS_LOAD(st + 1);
        const LAS unsigned char* kb = L + (st & 1) * IX_BUF;
#pragma unroll
        for (int jj = 0; jj < 4; ++jj) { const int j = kh * 4 + jj; f32x16 acc = {};
#pragma unroll
            for (int ks = 0; ks < 4; ++ks) acc = __builtin_amdgcn_mfma_f32_32x32x16_bf16(afr[ks], *(const LAS bf16x8*)(kb + (32 * j + r32) * IX_KST + (16 * ks + 8 * hh) * 2), acc, 0, 0, 0);
            float I = 0.f;
#pragma unroll
            for (int r = 0; r < 16; ++r) I += wv[r] * __builtin_amdgcn_fmed3f(acc[r], 0.f, __builtin_inff());
            asm volatile("" : "+v"(I) :: "memory");
            SC[(size_t)(b * 8 + 2 * a + hh) * SC_LD + 1024 * pg + 256 * st + 32 * j + r32] = I; }
        if (st < 3) SS_STORE((st + 1) & 1);
        __syncthreads();
    }
#undef SS_LOAD
#undef SS_STORE
}

__device__ __forceinline__ float wave_max(float v) {
#pragma unroll
    for (int o = 1; o < 64; o <<= 1) v = fmaxf(v, __shfl_xor(v, o));
    return v;
}
constexpr int SG_RED = 0  , SG_NSC = 256  , SG_WPFX = 320  , SG_SEL = 512  , SG_LG = 2048  , SG_ACC = 12288  , SG_END = 12288 + 16384;

__device__ __forceinline__ void sample_select_gather_unit(LAS unsigned char* L, unsigned char* ws, const float* out, const float* cache_k, const float* cache_v, const int* page_table, int b, int t, int tid) {
    const int lane = tid & 63, wave = __builtin_amdgcn_readfirstlane(tid >> 6);
    const bf16* QI = (const bf16*)(ws + WS_QI); const bf16* KI = (const bf16*)(ws + WS_KI); const float* WI = (const float*)(ws + WS_WI); const float* SC = (const float*)(ws + WS_SCORES);
    const bf16* QB = (const bf16*)(ws + WS_QB); const bf16* GB = (const bf16*)(ws + WS_GB); bf16* MIX = (bf16*)(ws + WS_MIX);
    const int row = MP + b * 8 + t;
    LAS float* red = (LAS float*)(L + SG_RED); LAS float* nsc = (LAS float*)(L + SG_NSC); LAS int* wpfx = (LAS int*)(L + SG_WPFX); LAS int* sel = (LAS int*)(L + SG_SEL);
    LAS float* lg = (LAS float*)(L + SG_LG); LAS float* accb = (LAS float*)(L + SG_ACC);
    { const int j = wave, h = lane >> 2, part = lane & 3; const bf16* qp = QI + (size_t)row * 1024 + h * 64 + 16 * part; const bf16* kp = KI + (size_t)(MP + b * 8 + j) * 64 + 16 * part;
      const v4u q0 = *(const v4u*)qp, q1 = *(const v4u*)(qp + 8), k0 = *(const v4u*)kp, k1 = *(const v4u*)(kp + 8);
      const unsigned qa[8] = {q0.x, q0.y, q0.z, q0.w, q1.x, q1.y, q1.z, q1.w}, ka[8] = {k0.x, k0.y, k0.z, k0.w, k1.x, k1.y, k1.z, k1.w}; float d = 0.f;
#pragma unroll
      for (int i = 0; i < 8; ++i) { d += __builtin_bit_cast(float, qa[i] << 16) * __builtin_bit_cast(float, ka[i] << 16); d += __builtin_bit_cast(float, qa[i] & 0xffff0000u) * __builtin_bit_cast(float, ka[i] & 0xffff0000u); }
      d += __shfl_xor(d, 1); d += __shfl_xor(d, 2);
      float s = WI[(size_t)row * 16 + h] * fmaxf(d, 0.f);
      s += __shfl_xor(s, 4); s += __shfl_xor(s, 8); s += __shfl_xor(s, 16); s += __shfl_xor(s, 32);
      if (lane == 0) nsc[j] = (j <= t) ? s : -__builtin_inff(); }
    float sv[17];
#pragma unroll
    for (int i = 0; i < 16; ++i) sv[i] = SC[(size_t)(b * 8 + t) * SC_LD + tid + 512 * i];
    __syncthreads();
    sv[16] = tid < 8 ? nsc[tid] : -__builtin_inff();
    float tau;
    { float s1 = 0.f, s2 = 0.f;
#pragma unroll
      for (int i = 0; i < 17; ++i) { const float v = (sv[i] > -3.0e38f) ? sv[i] : 0.f; s1 += v; s2 += v * v; }
      s1 = wave_sum(s1); s2 = wave_sum(s2);
      if (lane == 0) { red[wave * 2] = s1; red[wave * 2 + 1] = s2; }
      __syncthreads();
      float a1 = 0.f, a2 = 0.f;
#pragma unroll
      for (int w = 0; w < 8; ++w) { a1 += red[w * 2]; a2 += red[w * 2 + 1]; }
      const float n = (float)(PAST + t + 1); const float mu = a1 / n; const float sd = sqrtf(fmaxf(a2 / n - mu * mu, 1e-30f));
      const float p = 256.f / n; const float z = logf((1.f - p) / p) * (1.f / 1.702f);
      float lo = 0.f, hi = 0.f, clo = 0.f, chi = 0.f; bool hlo = false, hhi = false, done = false; float cand = mu + z * sd, step = 0.25f * sd; tau = -3.0e38f;
      for (int it = 0; it < 64 && !done; ++it) {
          int cnt = 0;
#pragma unroll
          for (int i = 0; i < 17; ++i) cnt += (sv[i] >= cand) ? 1 : 0;
          float cf = wave_sum((float)cnt);
          LAS float* rb = red + 16 + (it & 1) * 8;
          if (lane == 0) rb[wave] = cf;
          __syncthreads();
          float C = 0.f;
#pragma unroll
          for (int w = 0; w < 8; ++w) C += rb[w];
          if (C == 256.f) { tau = cand; done = true; }
          else {
              if (C > 256.f) { lo = cand; clo = C; hlo = true; } else { hi = cand; chi = C; hhi = true; }
              float nx;
              if (hlo && hhi) { float fr = (clo - 256.f) / (clo - chi); fr = fminf(fmaxf(fr, 0.02f), 0.98f); if ((it & 3) == 3) fr = 0.5f; nx = lo + (hi - lo) * fr;
                  if (!(nx > lo) || !(nx < hi)) { nx = 0.5f * lo + 0.5f * hi; if (!(nx > lo) || !(nx < hi)) { tau = lo; done = true; } } }
              else { nx = (C > 256.f) ? cand + step : cand - step; step *= 2.f; }
              cand = nx; }
      }
      if (!done) tau = hlo ? lo : -3.0e38f; }
    { int c = 0;
#pragma unroll
      for (int i = 0; i < 17; ++i) c += (sv[i] >= tau) ? 1 : 0;
      int inc = c;
#pragma unroll
      for (int o = 1; o < 64; o <<= 1) { const int x = __shfl_up(inc, o); if (lane >= o) inc += x; }
      if (lane == 63) wpfx[wave] = inc;
      if (tid < 256) sel[tid] = -1;
      __syncthreads();
      int base = inc - c;
#pragma unroll
      for (int w = 0; w < 8; ++w) if (w < wave) base += wpfx[w];
#pragma unroll
      for (int i = 0; i < 17; ++i) if (sv[i] >= tau) { if (base < 256) sel[base] = (i < 16) ? tid + 512 * i : PAST + tid; ++base; }
      __syncthreads(); }
    float qf[8]; { const v4u qv = *(const v4u*)(QB + (size_t)row * 512 + 8 * lane); const unsigned qa[4] = {qv.x, qv.y, qv.z, qv.w};
#pragma unroll
        for (int i = 0; i < 4; ++i) { qf[2 * i] = __builtin_bit_cast(float, qa[i] << 16); qf[2 * i + 1] = __builtin_bit_cast(float, qa[i] & 0xffff0000u); } }
    const float* newk = out + O_KS + (size_t)(b * 8) * 512; const float* newv = out + O_VS + (size_t)(b * 8) * 512;
#pragma unroll 4
    for (int kk = 0; kk < 32; ++kk) { const int slot = wave * 32 + kk; const int idx = sel[slot]; float d = 0.f;
        if (idx >= 0) { const float* kr = idx < PAST ? cache_k + ((size_t)page_table[b * NPAGES + (idx >> 7)] * PAGE + (idx & 127)) * 512 : newk + (size_t)(idx - PAST) * 512;
            const f32x4 k0 = *(const f32x4*)(kr + 8 * lane), k1 = *(const f32x4*)(kr + 8 * lane + 4);
            d = (qf[0] * k0[0] + qf[1] * k0[1]) + (qf[2] * k0[2] + qf[3] * k0[3]) + (qf[4] * k1[0] + qf[5] * k1[1]) + (qf[6] * k1[2] + qf[7] * k1[3]); }
        d += __shfl_xor(d, 1); d += __shfl_xor(d, 2); d += __shfl_xor(d, 4);
        if ((lane & 7) == 0) lg[slot * 8 + (lane >> 3)] = idx >= 0 ? d : -__builtin_inff(); }
    __syncthreads();
    { const int h = wave; float x[4]; float m = -__builtin_inff();
#pragma unroll
      for (int i = 0; i < 4; ++i) { x[i] = lg[(lane + 64 * i) * 8 + h]; m = fmaxf(m, x[i]); }
      m = wave_max(m); float s = 0.f;
#pragma unroll
      for (int i = 0; i < 4; ++i) { x[i] = ex2(x[i] - m); s += x[i]; }
      s = wave_sum(s); const float rs = 1.0f / s;
#pragma unroll
      for (int i = 0; i < 4; ++i) lg[(lane + 64 * i) * 8 + h] = x[i] * rs; }
    __syncthreads();
    float acc[8] = {0.f, 0.f, 0.f, 0.f, 0.f, 0.f, 0.f, 0.f};
#pragma unroll 4
    for (int kk = 0; kk < 32; ++kk) { const int slot = wave * 32 + kk; const int idx = sel[slot];
        if (idx >= 0) { const float* vr = idx < PAST ? cache_v + ((size_t)page_table[b * NPAGES + (idx >> 7)] * PAGE + (idx & 127)) * 512 : newv + (size_t)(idx - PAST) * 512;
            const f32x4 v0 = *(const f32x4*)(vr + 8 * lane), v1 = *(const f32x4*)(vr + 8 * lane + 4); const float p = lg[slot * 8 + (lane >> 3)];
            acc[0] += p * v0[0]; acc[1] += p * v0[1]; acc[2] += p * v0[2]; acc[3] += p * v0[3]; acc[4] += p * v1[0]; acc[5] += p * v1[1]; acc[6] += p * v1[2]; acc[7] += p * v1[3]; } }
    *(LAS f32x4*)(accb + wave * 512 + 8 * lane) = (f32x4){acc[0], acc[1], acc[2], acc[3]}; *(LAS f32x4*)(accb + wave * 512 + 8 * lane + 4) = (f32x4){acc[4], acc[5], acc[6], acc[7]};
    __syncthreads();
    { float o = 0.f;
#pragma unroll
      for (int w = 0; w < 8; ++w) o += accb[w * 512 + tid];
      MIX[(size_t)row * 1024 + 512 + tid] = (bf16)f2bf(o * bf2f(GB[(size_t)row * 512 + tid])); }
    __syncthreads();
}
struct Args { const float* in[15]; float* out; unsigned char* ws; };

__device__ __forceinline__ void p0_transpose_item(const float* W, int K, int N, bf16* WT, int drow, int scol, int valid, int k0, LAS float* scr, int lane) {
#pragma unroll 8
    for (int i = 0; i < 32; ++i) { const int kk = 2 * i + (lane >> 5); scr[kk * 33 + (lane & 31)] = ((lane & 31) < valid) ? W[(size_t)(k0 + kk) * N + scol + (lane & 31)] : 0.f; }
    LDS_WAIT(); asm volatile("" ::: "memory");
    const int c = lane & 7;
#pragma unroll
    for (int j = 0; j < 4; ++j) { const int n = (lane >> 3) + 8 * j; const LAS float* s = scr + (8 * c) * 33 + n;
        v4u o; o.x = pk2(s[0 * 33], s[1 * 33]); o.y = pk2(s[2 * 33], s[3 * 33]); o.z = pk2(s[4 * 33], s[5 * 33]); o.w = pk2(s[6 * 33], s[7 * 33]);
        *(GAS v4u*)(WT + (size_t)(drow + n) * K + k0 + 8 * c) = o; }
    LDS_WAIT(); asm volatile("" ::: "memory");
}

__device__ __forceinline__ float rope_inv(int j) {
    return j == 0 ? 1.0f : j == 1 ? 0.1939227432012558f : j == 2 ? 0.03760603070259094f : j == 3 ? 0.007292664609849453f : j == 4 ? 0.0014142135623842478f : j == 5 ? 0.00027424818836152554f : j == 6 ? 5.3182957344688475e-05f : 1.0313385246263351e-05f; }
__device__ __forceinline__ void sincos_acc(float angf, float& cs, float& sn) {
    const double x = (double)angf; const double kq = __builtin_rint(x * 0.63661977236758134308);
    const double r = (x - kq * 1.57079632679489655800e+00) - kq * 6.12323399573676603587e-17; const double r2 = r * r;
    double s = -1.0 / 1307674368000.0; s = s * r2 + 1.0 / 6227020800.0; s = s * r2 - 1.0 / 39916800.0; s = s * r2 + 1.0 / 362880.0; s = s * r2 - 1.0 / 5040.0; s = s * r2 + 1.0 / 120.0; s = s * r2 - 1.0 / 6.0; s = s * r2 * r + r;
    double c = 1.0 / 87178291200.0; c = c * r2 - 1.0 / 479001600.0; c = c * r2 + 1.0 / 3628800.0; c = c * r2 - 1.0 / 40320.0; c = c * r2 + 1.0 / 720.0; c = c * r2 - 1.0 / 24.0; c = c * r2 + 0.5; c = 1.0 - c * r2;
    const int q = ((int)kq) & 3;
    const double cc = (q == 0) ? c : (q == 1) ? -s : (q == 2) ? -c : s; const double ss = (q == 0) ? s : (q == 1) ? c : (q == 2) ? -s : -c;
    cs = (float)cc; sn = (float)ss; }

#ifndef REP_IDX
#define REP_IDX 1
#endif
#ifndef REP_ATT
#define REP_ATT 1
#endif
#ifndef REP_SMP
#define REP_SMP 1
#endif
#ifndef REP_HG
#define REP_HG 1
#endif
typedef const __attribute__((address_space(4))) Args* kargp_t;
__device__ __forceinline__ kargp_t kargs() { kargp_t p = (kargp_t)__builtin_amdgcn_kernarg_segment_ptr(); asm volatile("" : "+s"(p)); return p; }
__device__ __forceinline__ int opaque_tid() { int t = threadIdx.x; asm volatile("" : "+v"(t)); return t; }

__global__ void __launch_bounds__(NTHR, 2) hymba_fwd(Args args_unused) {
    extern __shared__ __attribute__((aligned(16))) unsigned char lds[];
    LAS unsigned char* L = (LAS unsigned char*)lds;
    XcdBarrier bar;
    {
        volatile LAS unsigned* MISC = (volatile LAS unsigned*)(L + MISC_OFF);
        const int tid = opaque_tid();
        if (tid < 64) MISC[tid] = 0u;
        __syncthreads();
        bar = xcd_barrier_post((unsigned*)((gu32*)(kargs()->ws + WS_CTL) + CW_BAR), MISC + 8);
    }

    {
        kargp_t A = kargs(); unsigned char* ws = A->ws; const float* x_p = A->in[0]; const float* x_s = A->in[1]; const float* w_in = A->in[7]; const float* lb_logits = A->in[8]; const float* w_out = A->in[12];
        bf16* WINT = (bf16*)(ws + WS_WINT); bf16* WOUTT = (bf16*)(ws + WS_WOUTT); float* ROPE = (float*)(ws + WS_ROPE); float* LBV = (float*)(ws + WS_LBV); bf16* XB = (bf16*)(ws + WS_XB);
        const int tid = opaque_tid(), lane = tid & 63, wave = __builtin_amdgcn_readfirstlane(tid >> 6); const int G = gridDim.x, bid = blockIdx.x;
        if (bid == 0) { const float l0 = lb_logits[tid], l1 = lb_logits[512 + tid]; LBV[tid] = 1.0f / (1.0f + expf(l1 - l0)); }
        { const int gi = bid * NTHR + tid;
          if (gi < 2056 * 8) { const int p = gi >> 3, j = gi & 7; const int pos = p < 2048 ? p : PAST + (p - 2048);
              const float inv = rope_inv(j); const float ang = (float)pos * inv; float cs, sn; sincos_acc(ang, cs, sn); ROPE[2 * gi] = cs; ROPE[2 * gi + 1] = sn; } }
        asm volatile("" ::: "memory");
        LAS float* scr = (LAS float*)(L + wave * 16384);
        const int gw = bid * NWAVES + wave, NGW = G * NWAVES;
        constexpr int I_IN = 16 * 168, I_OUT = 16 * 32;
        for (int it = gw; it < I_IN + I_OUT; it += NGW) {
            if (it < I_IN) {
                const int kb = it / 168, nb = it % 168; int scol = 32 * nb, valid = 32;
                if (nb >= 160) { const int j = nb - 160; if (j == 0) { scol = 5120; } else if (j == 1) { scol = 5184; valid = 16; } else if (j == 4) { scol = 5152; } else { scol = 0; valid = 0; } }
                p0_transpose_item(w_in, DM, DIN, WINT, 32 * nb, scol, valid, 64 * kb, scr, lane);
            } else { const int r = it - I_IN, kb = r / 32, nb = r % 32; p0_transpose_item(w_out, DM, DM, WOUTT, 32 * nb, 32 * nb, 32, 64 * kb, scr, lane); }
        }
        const size_t gt = (size_t)bid * NTHR + tid, NGT = (size_t)G * NTHR;
        for (size_t i = gt; i < (size_t)M * DM / 8; i += NGT) {
            const size_t e = i * 8; const float* src = e < (size_t)MP * DM ? x_p + e : x_s + (e - (size_t)MP * DM);
            const f32x4 a = *(const f32x4*)src, b = *(const f32x4*)(src + 4);
            v4u o; o.x = pk2(a[0], a[1]); o.y = pk2(a[2], a[3]); o.z = pk2(b[0], b[1]); o.w = pk2(b[2], b[3]);
            *(GAS v4u*)(XB + e) = o;
        }
    }
    xcd_barrier(bar);

    {
        kargp_t A = kargs(); unsigned char* ws = A->ws; const int G = gridDim.x, bid = blockIdx.x;
        pg8::Gemm g{(const bf16*)(ws + WS_XB), (const bf16*)(ws + WS_WINT), M, NPAD, DM}; pg8::StaticOrder S; S.init(M, NPAD, G, bid);
        pg8::EpiIn E; E.ws = ws; E.out = A->out; E.kn_g = A->in[10]; E.kn_b = A->in[11];
        pg8::gemm_phase<pg8::EpiIn, pg8::StaticOrder, true, true>(L, g, S, E);
    }
    xcd_barrier(bar);

    {
        kargp_t A = kargs(); unsigned char* ws = A->ws; const int tid = opaque_tid(); const int G = gridDim.x, bid = blockIdx.x;
        for (int uu = bid; uu < 256 * REP_HG; uu += G) hgrn_prompt_unit<false>(L, ws, A->out, A->in[9], uu & 255, tid);
        for (int u = bid; u < 128; u += G) hgrn_sample_unit(L, ws, A->out, A->in[5], A->in[9], u, tid);
    }
    {
        kargp_t A = kargs(); unsigned char* ws = A->ws; const int tid = opaque_tid(); const int G = gridDim.x, bid = blockIdx.x;
        for (int pp = bid; pp < 1024 * REP_IDX; pp += G) { const int p = pp & 1023, b = (p & 511) >> 6, j = p & 63; indexer_prompt_unit(L, ws, b, p < 512 ? 127 - j : j, tid); }
    }
    {
        kargp_t A = kargs(); unsigned char* ws = A->ws; const int tid = opaque_tid(); const int G = gridDim.x, bid = blockIdx.x;
        for (int uu = bid; uu < 256 * REP_SMP; uu += G) { const int u = uu & 255; sample_scores_unit(L, ws, A->in[4], (const int*)A->in[6], u >> 3, u & 7, tid); }
    }
    xcd_barrier(bar);

    {
        kargp_t A = kargs(); unsigned char* ws = A->ws; const int tid = opaque_tid(); const int G = gridDim.x, bid = blockIdx.x;
        for (int uu = bid; uu < 256 * REP_HG; uu += G) hgrn_prompt_unit<true>(L, ws, A->out, A->in[9], uu & 255, tid);
    }
    {
        kargp_t A = kargs(); unsigned char* ws = A->ws; const int tid = opaque_tid(); const int G = gridDim.x, bid = blockIdx.x;
        for (int uu = bid; uu < 256 * REP_SMP; uu += G) { const int u = uu & 255; sample_select_gather_unit(L, ws, A->out, A->in[2], A->in[3], (const int*)A->in[6], u >> 3, u & 7, tid); }
    }
    {
        kargp_t A = kargs(); unsigned char* ws = A->ws; const int G = gridDim.x, bid = blockIdx.x;
        const int vcu = (G % 8 == 0) ? (bid % 8) * (G / 8) + bid / 8 : bid;
        for (int pp = vcu; pp < 512 * REP_ATT; pp += G) { const int p = pp & 511, bh = (p & 255) >> 2, s = p & 3; const int qb = p < 256 ? 7 - s : s;
            attn_body::attn_unit<8>(bh >> 3, bh & 7, qb, (const attn_body::bf16*)(ws + WS_QB), (const attn_body::bf16*)(ws + WS_KB), (const attn_body::bf16*)(ws + WS_VB), (const unsigned*)(ws + WS_MASK), (const unsigned short*)(ws + WS_GB), (unsigned short*)(ws + WS_MIX), (char*)lds); }
    }
    xcd_barrier(bar);

    {
        kargp_t A = kargs(); unsigned char* ws = A->ws; const int G = gridDim.x, bid = blockIdx.x;
        pg8::Gemm g{(const bf16*)(ws + WS_MIX), (const bf16*)(ws + WS_WOUTT), M, DM, DM}; pg8::StaticOrder S; S.init(M, DM, G, bid);
        pg8::EpiF32 E{(float*)(ws + WS_Y), DM};
        pg8::gemm_phase<pg8::EpiF32, pg8::StaticOrder, true, true>(L, g, S, E);
    }
    xcd_barrier(bar);

    {
        kargp_t A = kargs(); unsigned char* ws = A->ws; const float* x_p = A->in[0]; const float* x_s = A->in[1]; float* out = A->out;
        const int tid = opaque_tid(), lane = tid & 63, wave = __builtin_amdgcn_readfirstlane(tid >> 6); const int G = gridDim.x, bid = blockIdx.x;
        const float* ln_g = A->in[13]; const float* ln_b = A->in[14]; const float* Y = (const float*)(ws + WS_Y);
        const int gw = bid * NWAVES + wave, NGW = G * NWAVES;
        for (int m = gw; m < M; m += NGW) {
            const float* xr = m < MP ? x_p + (size_t)m * DM : x_s + (size_t)(m - MP) * DM; float* orow = out + (m < MP ? O_YP + (size_t)m * DM : O_YS + (size_t)(m - MP) * DM);
            f32x4 v[4]; float sm = 0.f;
#pragma unroll
            for (int j = 0; j < 4; ++j) { const f32x4 a = *(const f32x4*)(xr + 256 * j + 4 * lane), y = *(const f32x4*)(Y + (size_t)m * DM + 256 * j + 4 * lane); v[j] = a * ALPHA + y; sm += (v[j][0] + v[j][1]) + (v[j][2] + v[j][3]); }
            const float mean = wave_sum(sm) * (1.f / DM); float s2 = 0.f;
#pragma unroll
            for (int j = 0; j < 4; ++j) { v[j] = v[j] - mean; s2 += (v[j][0] * v[j][0] + v[j][1] * v[j][1]) + (v[j][2] * v[j][2] + v[j][3] * v[j][3]); }
            const float rstd = 1.f / sqrtf(wave_sum(s2) * (1.f / DM) + LN_EPS);
#pragma unroll
            for (int j = 0; j < 4; ++j) { const f32x4 gg = *(const f32x4*)(ln_g + 256 * j + 4 * lane), bb = *(const f32x4*)(ln_b + 256 * j + 4 * lane); *(f32x4*)(orow + 256 * j + 4 * lane) = v[j] * rstd * gg + bb; }
        }
    }
}

extern "C" void kernel_launch(void* const* d_in, const int* in_sizes, int n_in, void* d_out, int out_size, void* d_ws, size_t ws_size, hipStream_t stream) {
    static int grid = 0;
    if (grid == 0) {
        if (n_in != 15 || (size_t)out_size != O_END || ws_size < WS_END) { fprintf(stderr, "kernel_launch: unexpected shapes (n_in %d out %d ws %zu)\n", n_in, out_size, ws_size); grid = -1; return; }
        int dev = 0, cus = 0, per_cu = 0;
        if (hipGetDevice(&dev) != hipSuccess || hipDeviceGetAttribute(&cus, hipDeviceAttributeMultiprocessorCount, dev) != hipSuccess) { grid = -1; return; }
        if (hipFuncSetAttribute((const void*)hymba_fwd, hipFuncAttributeMaxDynamicSharedMemorySize, LDS_BYTES) != hipSuccess) { fprintf(stderr, "kernel_launch: hipFuncSetAttribute failed\n"); grid = -1; return; }
        if (hipOccupancyMaxActiveBlocksPerMultiprocessor(&per_cu, (const void*)hymba_fwd, NTHR, LDS_BYTES) != hipSuccess || per_cu < 1) fprintf(stderr, "kernel_launch: occupancy query reports %d\n", per_cu);
        (void)hipGetLastError();
        grid = cus;
    }
    if (grid < 0) return;
    if (hipMemsetAsync((char*)d_ws + WS_CTL, 0, CTL_ZERO_BYTES, stream) != hipSuccess) return;
    Args a{};
    for (int i = 0; i < 15; ++i) a.in[i] = (const float*)d_in[i];
    a.out = (float*)d_out; a.ws = (unsigned char*)d_ws;
    hipLaunchKernelGGL(hymba_fwd, dim3(grid), dim3(NTHR), LDS_BYTES, stream, a);
}
```
